# Optimizing an MI355X kernel written in HIP

```python
import jax, jax.numpy as jnp
from jax import lax
import numpy as np


D_MODEL = 1024
BATCH = 4
SEQ = 8192
DEPTH = 1

CHUNK = 64
ROPE_THETA = 10000.0
LN_EPS = 1e-5
DSA_WIDTH = D_MODEL // 2
DSA_HEAD_DIM = 64
DSA_HEADS = DSA_WIDTH // DSA_HEAD_DIM
IDX_HEADS = 8
IDX_DIM = 32
IDX_SCALE = (IDX_HEADS * IDX_DIM) ** -0.5
DSA_TOPK_MAX = 256
Q_BLOCK = CHUNK
GLA_WIDTH = D_MODEL - DSA_WIDTH
GLA_HEADS = 4
GLA_DV = GLA_WIDTH // GLA_HEADS
GLA_DK = GLA_DV // 2
GLA_GATE_RANK = 16
GLA_TAU = 16.0
N_GROUPS = 4
EXPERTS_PER_GROUP = 8
N_EXPERTS = N_GROUPS * EXPERTS_PER_GROUP
TOP_K_INNER = 2
D_EXPERT = 512
DEEPNORM_ALPHA = (2.0 * DEPTH) ** 0.25
DEEPNORM_BETA = (8.0 * DEPTH) ** -0.25
IN_SIZES = (DSA_WIDTH, DSA_WIDTH, DSA_WIDTH, IDX_HEADS * IDX_DIM, IDX_DIM, IDX_HEADS,
            GLA_HEADS * GLA_DK, GLA_HEADS * GLA_DK, GLA_WIDTH, GLA_WIDTH, GLA_GATE_RANK)
IN_WIDTH = sum(IN_SIZES)

kernel_name = 'hybrid_dsa_gla_hmoe_block'


def layer_norm(x, g, b):
    xf = x.astype(jnp.float32)
    mu = jnp.mean(xf, axis=-1, keepdims=True)
    var = jnp.mean(jnp.square(xf - mu), axis=-1, keepdims=True)
    return ((xf - mu) * lax.rsqrt(var + LN_EPS) * g + b).astype(x.dtype)


def rope(x, pos):
    d = x.shape[-1]
    half = d // 2
    inv = 1.0 / (ROPE_THETA ** (jnp.arange(half, dtype=jnp.float32) / half))
    ang = pos.astype(jnp.float32)[:, None] * inv[None, :]
    cos = jnp.cos(ang)[:, None, :].astype(x.dtype)
    sin = jnp.sin(ang)[:, None, :].astype(x.dtype)
    x1, x2 = x[..., :half], x[..., half:]
    return jnp.concatenate([x1 * cos - x2 * sin, x2 * cos + x1 * sin], axis=-1)


def dsa_mixer(q, k, v, iq, ik, iw):
    B, T, H, dh = q.shape
    topk = min(DSA_TOPK_MAX, T // 4)
    nb = T // Q_BLOCK
    key_chunk = jnp.arange(T) // CHUNK

    def block(args):
        qb, iqb, iwb, start = args
        qpos = start + jnp.arange(Q_BLOCK)
        adm = key_chunk[None, :] <= (qpos // CHUNK)[:, None]
        rel = jax.nn.relu(jnp.einsum('bqhd,bsd->bqhs', iqb, ik))
        score = jnp.einsum('bqhs,bqh->bqs', rel, iwb).astype(jnp.float32)
        score = jnp.where(adm[None], score, -jnp.inf)
        vals, idx = lax.top_k(score, topk)
        ksel = jax.vmap(lambda kb, ib: kb[ib])(k, idx)
        vsel = jax.vmap(lambda vb, ib: vb[ib])(v, idx)
        s = jnp.einsum('bqhd,bqkhd->bhqk', qb, ksel).astype(jnp.float32) * (dh ** -0.5)
        s = jnp.where(jnp.isfinite(vals)[:, None], s, -jnp.inf)
        p = jax.nn.softmax(s, axis=-1).astype(v.dtype)
        return jnp.einsum('bhqk,bqkhd->bqhd', p, vsel)

    qbs = q.reshape(B, nb, Q_BLOCK, H, dh).transpose(1, 0, 2, 3, 4)
    iqbs = iq.reshape(B, nb, Q_BLOCK, IDX_HEADS, IDX_DIM).transpose(1, 0, 2, 3, 4)
    iwbs = iw.reshape(B, nb, Q_BLOCK, IDX_HEADS).transpose(1, 0, 2, 3)
    starts = jnp.arange(nb, dtype=jnp.int32) * Q_BLOCK
    out = lax.map(block, (qbs, iqbs, iwbs, starts))
    return out.transpose(1, 0, 2, 3, 4).reshape(B, T, H * dh)


def gla_mixer(q, k, v, log_a):
    B, T, H, dk = q.shape
    dv = v.shape[-1]
    N, C = T // CHUNK, CHUNK
    qf = q.astype(jnp.float32).reshape(B, N, C, H, dk) * (dk ** -0.5)
    kf = k.astype(jnp.float32).reshape(B, N, C, H, dk)
    vf = v.astype(jnp.float32).reshape(B, N, C, H, dv)
    b = jnp.cumsum(log_a.reshape(B, N, C, H, dk), axis=2)
    qg = qf * jnp.exp(b)
    kg = kf * jnp.exp(-b)
    causal = jnp.tril(jnp.ones((C, C), dtype=bool))
    A = jnp.where(causal, jnp.einsum('bnihd,bnjhd->bnhij', qg, kg), 0.0)
    o_intra = jnp.einsum('bnhij,bnjhv->bnihv', A, vf)
    b_last = b[:, :, -1]
    kd = kf * jnp.exp(b_last[:, :, None] - b)
    kv = jnp.einsum('bnjhd,bnjhv->bnhdv', kd, vf)
    decay = jnp.exp(b_last)

    def step(S, inp):
        dec, kvn = inp
        return dec[..., None] * S + kvn, S

    S0 = jnp.zeros((B, H, dk, dv), jnp.float32)
    _, S_prev = lax.scan(step, S0, (decay.transpose(1, 0, 2, 3), kv.transpose(1, 0, 2, 3, 4)))
    S_prev = S_prev.transpose(1, 0, 2, 3, 4)
    o_inter = jnp.einsum('bnihd,bnhdv->bnihv', qg, S_prev)
    return (o_intra + o_inter).reshape(B, T, H, dv)


def hier_moe(x, w_gr, b_gr, w_er, b_er, w_e_in, w_e_out):
    B, T, D = x.shape
    xt = x.reshape(-1, D)
    Ntok = xt.shape[0]
    glog = (xt @ w_gr + b_gr).astype(jnp.float32)
    gsel = jnp.argmax(glog, axis=-1)
    pg = jnp.take_along_axis(jax.nn.softmax(glog, axis=-1), gsel[:, None], axis=-1)
    elog = (xt @ w_er + b_er).astype(jnp.float32).reshape(Ntok, N_GROUPS, EXPERTS_PER_GROUP)
    elog_g = jnp.take_along_axis(elog, gsel[:, None, None], axis=1)[:, 0]
    tv, te = lax.top_k(elog_g, TOP_K_INNER)
    gate = jax.nn.softmax(tv, axis=-1) * pg
    eid = (gsel[:, None] * EXPERTS_PER_GROUP + te).reshape(-1)
    tok = jnp.repeat(jnp.arange(Ntok), TOP_K_INNER)
    order = jnp.argsort(eid)
    tok_s = tok[order]
    gate_s = gate.reshape(-1)[order]
    sizes = jnp.bincount(eid, length=N_EXPERTS).astype(jnp.int32)
    xs = xt[tok_s]
    h = lax.ragged_dot(xs, w_e_in, sizes)
    hg, hu = jnp.split(h, 2, axis=-1)
    y = lax.ragged_dot(jax.nn.silu(hg) * hu, w_e_out, sizes)
    out = jnp.zeros_like(xt).at[tok_s].add(y * gate_s[:, None].astype(y.dtype))
    return out.reshape(B, T, D)


def setup_inputs(seed: int = 0) -> dict:
    key = jax.random.key(seed)
    ks = jax.random.split(key, 16)

    def nrm(k, shape, scale):
        return jax.random.normal(k, shape, jnp.float32) * scale

    return {
        'x': nrm(ks[0], (BATCH, SEQ, D_MODEL), 1.0),
        'w_in': nrm(ks[1], (DEPTH, D_MODEL, IN_WIDTH), D_MODEL ** -0.5),
        'w_gla_gate': nrm(ks[2], (DEPTH, GLA_GATE_RANK, GLA_HEADS * GLA_DK), GLA_GATE_RANK ** -0.5),
        'b_gla_gate': nrm(ks[3], (DEPTH, GLA_HEADS * GLA_DK), 0.1),
        'g_gla_norm': 1.0 + nrm(ks[4], (DEPTH, GLA_DV), 0.02),
        'w_out': nrm(ks[5], (DEPTH, D_MODEL, D_MODEL), D_MODEL ** -0.5 * DEEPNORM_BETA),
        'ln1_g': 1.0 + nrm(ks[6], (DEPTH, D_MODEL), 0.02),
        'ln1_b': nrm(ks[7], (DEPTH, D_MODEL), 0.02),
        'w_group_router': nrm(ks[8], (DEPTH, D_MODEL, N_GROUPS), D_MODEL ** -0.5),
        'b_group_router': nrm(ks[9], (DEPTH, N_GROUPS), 0.01),
        'w_expert_router': nrm(ks[10], (DEPTH, D_MODEL, N_EXPERTS), D_MODEL ** -0.5),
        'b_expert_router': nrm(ks[11], (DEPTH, N_EXPERTS), 0.01),
        'w_expert_in': nrm(ks[12], (DEPTH, N_EXPERTS, D_MODEL, 2 * D_EXPERT), D_MODEL ** -0.5),
        'w_expert_out': nrm(ks[13], (DEPTH, N_EXPERTS, D_EXPERT, D_MODEL), D_EXPERT ** -0.5 * DEEPNORM_BETA),
        'ln2_g': 1.0 + nrm(ks[14], (DEPTH, D_MODEL), 0.02),
        'ln2_b': nrm(ks[15], (DEPTH, D_MODEL), 0.02),
    }


def reference(x, w_in, w_gla_gate, b_gla_gate, g_gla_norm, w_out, ln1_g, ln1_b,
              w_group_router, b_group_router, w_expert_router, b_expert_router,
              w_expert_in, w_expert_out, ln2_g, ln2_b):
    B, T, D = x.shape
    pos = jnp.arange(T)
    split_points = np.cumsum(np.array(IN_SIZES))[:-1].tolist()
    h = x
    for l in range(DEPTH):
        proj = h @ w_in[l]
        aq, ak, av, iq, ik, iw, bq, bk, bv, br, bg = jnp.split(proj, split_points, axis=-1)
        aq = rope(aq.reshape(B, T, DSA_HEADS, DSA_HEAD_DIM), pos)
        ak = rope(ak.reshape(B, T, DSA_HEADS, DSA_HEAD_DIM), pos)
        av = av.reshape(B, T, DSA_HEADS, DSA_HEAD_DIM)
        iq = rope(iq.reshape(B, T, IDX_HEADS, IDX_DIM), pos)
        ik = rope(ik[:, :, None, :], pos)[:, :, 0]
        iw = iw * IDX_SCALE
        ya = dsa_mixer(aq, ak, av, iq, ik, iw)
        log_a = jax.nn.log_sigmoid((bg @ w_gla_gate[l] + b_gla_gate[l]).astype(jnp.float32)) / GLA_TAU
        ob = gla_mixer(bq.reshape(B, T, GLA_HEADS, GLA_DK), bk.reshape(B, T, GLA_HEADS, GLA_DK),
                       bv.reshape(B, T, GLA_HEADS, GLA_DV), log_a.reshape(B, T, GLA_HEADS, GLA_DK))
        ob = ob * lax.rsqrt(jnp.mean(jnp.square(ob), axis=-1, keepdims=True) + LN_EPS) * g_gla_norm[l]
        yb = (ob.reshape(B, T, GLA_WIDTH) * jax.nn.silu(br.astype(jnp.float32))).astype(h.dtype)
        mix = jnp.concatenate([ya, yb], axis=-1) @ w_out[l]
        h = layer_norm(DEEPNORM_ALPHA * h + mix, ln1_g[l], ln1_b[l])
        ffn = hier_moe(h, w_group_router[l], b_group_router[l], w_expert_router[l], b_expert_router[l],
                       w_expert_in[l], w_expert_out[l])
        h = layer_norm(DEEPNORM_ALPHA * h + ffn, ln2_g[l], ln2_b[l])
    return h
```

```cpp
#include <hip/hip_runtime.h>
#include <hip/hip_bf16.h>
#include <cmath>
#include <cstdio>
#include <cstdint>
constexpr int NWAVES = 8;
constexpr int BATCH = 4, T = 8192, D = 1024, M = BATCH * T;
constexpr int NCHUNK = T / 64;
constexpr int IN_W = 3384, NPROJ = 3584;
constexpr float LN_EPS = 1e-5f;
constexpr float ALPHA = 1.189207115002721f;
constexpr float IDX_SCALE = 0.0625f;
constexpr float QK_C2 = 0.125f * 1.4426950408889634f;
constexpr size_t MiB = 1u << 20;
constexpr size_t WS_CTL = 0, CTL_ZERO_BYTES = 1 * MiB;
constexpr size_t WS_COS64 = 1 * MiB, WS_SIN64 = 2 * MiB, WS_COS32 = 3 * MiB, WS_SIN32 = 3 * MiB + 512 * 1024;
constexpr size_t WS_MOE = 4 * MiB;
constexpr size_t WS_WIN = 8 * MiB, WS_WO = 15 * MiB, WS_WEI = 32 * MiB, WS_WEO = 96 * MiB;
constexpr size_t WS_XB = 128 * MiB;
constexpr size_t WS_AQ = 192 * MiB, WS_AK = 224 * MiB, WS_AV = 256 * MiB;
constexpr size_t WS_IQ = 288 * MiB, WS_IK = 304 * MiB, WS_IW = 306 * MiB, WS_BG = 307 * MiB;
constexpr size_t WS_BQ = 312 * MiB, WS_BK = 328 * MiB, WS_BV = 344 * MiB, WS_BR = 376 * MiB;
constexpr size_t WS_MASK = 408 * MiB, WS_Y = 440 * MiB, WS_DEC = 504 * MiB;
constexpr size_t WS_HB = 128 * MiB, WS_XS = 192 * MiB, WS_HMID = 336 * MiB, WS_FFN2 = 192 * MiB;
constexpr size_t OUT_KVT = 0, OUT_SPREV = 64 * MiB;
constexpr int CW_TMO = 0, CW_CODE = 1, CW_BAR = 4096;
constexpr int RING_OFF = 0, RING_BYTES = 131072;
constexpr int LDSCTL_OFF = RING_BYTES, MISC_OFF = LDSCTL_OFF + 320;
constexpr int LDS_BYTES = 147456;

#define GAS __attribute__((address_space(1)))
#define LAS __attribute__((address_space(3)))
typedef unsigned short bf16;
typedef unsigned v4u __attribute__((ext_vector_type(4)));
typedef unsigned v2u __attribute__((ext_vector_type(2)));
typedef float f32x4 __attribute__((ext_vector_type(4)));
typedef float f32x2 __attribute__((ext_vector_type(2)));
typedef short bf16x8 __attribute__((ext_vector_type(8)));
typedef short s16x4 __attribute__((ext_vector_type(4)));
typedef GAS unsigned gu32;
#define RLX_AGENT __ATOMIC_RELAXED, __HIP_MEMORY_SCOPE_AGENT
#define LDS_WAIT() asm volatile("s_waitcnt lgkmcnt(0)" ::: "memory")
#define VM_WAIT() asm volatile("s_waitcnt vmcnt(0)" ::: "memory")
__device__ __forceinline__ unsigned f2bf(float f) { unsigned u = __builtin_bit_cast(unsigned, f); return (u + 0x7fffu + ((u >> 16) & 1u)) >> 16; }
__device__ __forceinline__ unsigned pk2(float lo, float hi) { return f2bf(lo) | (f2bf(hi) << 16); }
__device__ __forceinline__ float bf2f(unsigned short b) { return __builtin_bit_cast(float, (unsigned)b << 16); }
__device__ __forceinline__ unsigned pkh2(float lo, float hi) { const _Float16 a = (_Float16)lo, b = (_Float16)hi; return (unsigned)__builtin_bit_cast(unsigned short, a) | ((unsigned)__builtin_bit_cast(unsigned short, b) << 16); }
struct Args { const float* in[16]; float* out; unsigned char* ws; int ph_lo, ph_hi; };
namespace pg8 {
#define PG8_LAS __attribute__((address_space(3)))
typedef unsigned short bf16_t;
typedef short bf16x8 __attribute__((ext_vector_type(8)));
typedef float f32x4 __attribute__((ext_vector_type(4)));
typedef unsigned u32x4 __attribute__((ext_vector_type(4)));
constexpr int BM = 256, BK = 64, HALF = 128, HTB = HALF * BK * 2  , STAGE_BYTES = 8 * HTB, NXCD = 8, WGM = 8;

__host__ __device__ __forceinline__ int lds_byte(int r, int c) { const int st = (r >> 4) * 2 + (c >> 5), rr = r & 15, cc = c & 31, ob = rr * 64 + cc * 2; return st * 1024 + (ob ^ (((ob >> 9) & 1) << 5)); }
__host__ __device__ __forceinline__ void stage_rc(int b, int& R, int& C) { const int st = b / 1024, sb = b % 1024, swz = sb ^ (((sb >> 9) & 1) << 5); R = (st >> 1) * 16 + swz / 64; C = (st & 1) * 32 + (swz % 64) / 2; }
__host__ __device__ __forceinline__ int perm32(int rho) { const int n = rho >> 4, i = rho & 15; return 8 * (i >> 2) + 4 * n + (i & 3); }

struct Unit { int pm, pn; };
struct Gemm { const bf16_t* A; const bf16_t* Bt; int M, N, K; };

struct StaticOrder {
    int nM, nN, nwg, G, c;
    __host__ __device__ void init(int M, int N, int G_, int c_) { nM = M / BM; nN = N / BM; nwg = nM * nN; G = G_; c = c_; }
    __host__ __device__ bool next(int i, Unit& u) const {
        const long L = (long)i * G + c; if (L >= nwg) return false;
        int wgid = (int)L; { const int q = nwg / NXCD, r = nwg % NXCD, xcd = wgid % NXCD, off = wgid / NXCD; wgid = (xcd < r ? xcd * (q + 1) : r * (q + 1) + (xcd - r) * q) + off; }
        const int nig = WGM * nN, gid = wgid / nig, fm = gid * WGM, gsz = (nM - fm) < WGM ? (nM - fm) : WGM;
        u.pm = fm + ((wgid % nig) % gsz); u.pn = (wgid % nig) / gsz; return true;
    }
    __device__ __forceinline__ void a_ready(const Unit&) const {}
    __device__ __forceinline__ void done(const Unit&) const {}
};

__device__ __forceinline__ unsigned cvt_pk_bf16(float lo, float hi) { unsigned r; asm volatile("v_cvt_pk_bf16_f32 %0, %1, %2" : "=v"(r) : "v"(lo), "v"(hi)); return r; }
typedef float f32x2 __attribute__((ext_vector_type(2)));
__device__ __forceinline__ f32x2 gelu_pk(f32x2 v) {
    const f32x2 av = __builtin_elementwise_abs(v), d = av * 0.2316418882f + 1.0f;
    f32x2 t; t.x = __builtin_amdgcn_rcpf(d.x); t.y = __builtin_amdgcn_rcpf(d.y);
    f32x2 q = t * 0.5307027145f + (-0.7265760135f); q = q * t + 0.7107068705f; q = q * t + (-0.142248368f); q = q * t + 0.127414796f; q = q * t;
    const f32x2 s = (v * v) * (-0.72134752044f);
    f32x2 e; e.x = __builtin_amdgcn_exp2f(s.x); e.y = __builtin_amdgcn_exp2f(s.y);
    const f32x2 m = v * (q * e), r = v - m;
    f32x2 o; o.x = v.x < 0.f ? m.x : r.x; o.y = v.y < 0.f ? m.y : r.y; return o;
}

template <int ACT  > struct EpiBf16 {
    static constexpr bool PERM = true, AFTER_DRAIN = false; static_assert(ACT == 0 || ACT == 1, "EpiBf16: ACT is 0 (none) or 1 (gelu_pk)");
    bf16_t* O; int ldc; const float* bias; int split_cols; size_t split_stride; float scale0;
    __device__ __forceinline__ void operator()(const f32x4 (&acc)[2][2][4][2], const Unit& u, int wr, int wc, int fr, int fq) const {
        const int row0 = u.pm * BM + wr * 64 + fr; int colt = u.pn * BM; bf16_t* base = O;
        float sc = 1.f; if (split_cols) { const int t = colt / split_cols; base += (size_t)t * split_stride; colt -= t * split_cols; if (t == 0) sc = scale0; }
        const int col0 = colt + wc * 32 + 8 * fq, bcol0 = u.pn * BM + wc * 32 + 8 * fq;
        f32x4 bv[2][2];
#pragma unroll
        for (int bj = 0; bj < 2; ++bj)
#pragma unroll
            for (int n = 0; n < 2; ++n) bv[bj][n] = bias ? *(const f32x4*)(bias + bcol0 + bj * HALF + 4 * n) : (f32x4){0.f, 0.f, 0.f, 0.f};
#pragma unroll
        for (int ai = 0; ai < 2; ++ai)
#pragma unroll
            for (int m = 0; m < 4; ++m) { bf16_t* rowp = base + (size_t)(row0 + ai * HALF + m * 16) * ldc + col0;
#pragma unroll
                for (int bj = 0; bj < 2; ++bj) { f32x4 v0 = acc[ai][bj][m][0] + bv[bj][0], v1 = acc[ai][bj][m][1] + bv[bj][1];
                    if (ACT == 1) { f32x2 a = gelu_pk((f32x2){v0[0], v0[1]}), b = gelu_pk((f32x2){v0[2], v0[3]}), c = gelu_pk((f32x2){v1[0], v1[1]}), d = gelu_pk((f32x2){v1[2], v1[3]});
                        v0 = (f32x4){a.x, a.y, b.x, b.y}; v1 = (f32x4){c.x, c.y, d.x, d.y}; }
                    v0 = v0 * sc; v1 = v1 * sc; u32x4 w; w.x = cvt_pk_bf16(v0[0], v0[1]); w.y = cvt_pk_bf16(v0[2], v0[3]); w.z = cvt_pk_bf16(v1[0], v1[1]); w.w = cvt_pk_bf16(v1[2], v1[3]);
                    *(u32x4*)(rowp + bj * HALF) = w; } }
    }
};

struct PanelStats {
    unsigned* xbuf;
    unsigned* cnt;
    unsigned* tmo;
    int ntn; float eps;
    unsigned code;
    __device__ __forceinline__ bool run(const f32x4 (&v)[2][2][4][2], const Unit& u, int wr, int wc, int fr, int fq, PG8_LAS unsigned char* lds, int wid, int lane) const {
        typedef float f32x2v __attribute__((ext_vector_type(2)));
        PG8_LAS f32x2v* P = (PG8_LAS f32x2v*)lds;
        PG8_LAS f32x2v* S = (PG8_LAS f32x2v*)(lds + 8192);
        PG8_LAS unsigned* flag = (PG8_LAS unsigned*)(lds + 8192 + 2048);
#pragma unroll
        for (int ai = 0; ai < 2; ++ai)
#pragma unroll
            for (int m = 0; m < 4; ++m) {
                float s = 0.f;
#pragma unroll
                for (int bj = 0; bj < 2; ++bj)
#pragma unroll
                    for (int n = 0; n < 2; ++n) { const f32x4 x = v[ai][bj][m][n]; s += (x[0] + x[1]) + (x[2] + x[3]); }
                s += __shfl_xor(s, 16); s += __shfl_xor(s, 32);
                const float mw = s * (1.0f / 64.0f); float q = 0.f;
#pragma unroll
                for (int bj = 0; bj < 2; ++bj)
#pragma unroll
                    for (int n = 0; n < 2; ++n) { const f32x4 d = v[ai][bj][m][n] - mw; q += (d[0] * d[0] + d[1] * d[1]) + (d[2] * d[2] + d[3] * d[3]); }
                q += __shfl_xor(q, 16); q += __shfl_xor(q, 32);
                if (fq == 0) P[(ai * HALF + wr * 64 + m * 16 + fr) * 4 + wc] = (f32x2v){mw, q};
            }
        asm volatile("s_waitcnt lgkmcnt(0)" ::: "memory"); __builtin_amdgcn_s_barrier(); asm volatile("" ::: "memory");
#if defined(BROKEN_EXCHANGE_NO_WAIT)
#warning BROKEN CONTROL BUILD: the row-statistics exchange does not wait; results are wrong by design
        if (blockIdx.x >= 64) { const long long t0_ = clock64(); while (clock64() - t0_ < 60000) __builtin_amdgcn_s_sleep(8); }
#endif
        const int row = wid * 32 + (lane & 31);
        if (lane < 32) {
            const f32x2v a = P[row * 4 + 0], b = P[row * 4 + 1], c = P[row * 4 + 2], d = P[row * 4 + 3];
            const float mt = (a.x + b.x + c.x + d.x) * 0.25f;
            const float da = a.x - mt, db = b.x - mt, dc = c.x - mt, dd = d.x - mt;
            const float m2 = (a.y + b.y) + (c.y + d.y) + 64.0f * ((da * da + db * db) + (dc * dc + dd * dd));
            unsigned long long* slot = (unsigned long long*)xbuf + ((size_t)(u.pm * BM + row) * 4 + u.pn);
            __hip_atomic_store(slot, ((unsigned long long)__float_as_uint(m2) << 32) | __float_as_uint(mt), __ATOMIC_RELAXED, __HIP_MEMORY_SCOPE_AGENT);
        }
        asm volatile("s_waitcnt vmcnt(0)" ::: "memory");
        if (lane == 0) __hip_atomic_fetch_add(cnt + 64 * u.pm, 1u, __ATOMIC_RELAXED, __HIP_MEMORY_SCOPE_AGENT);
        if (wid == 0) {
            bool dead = false; const unsigned long long t0 = __builtin_amdgcn_s_memrealtime(); const unsigned want = 8u * (unsigned)ntn;
            for (;;) {
#if defined(BROKEN_EXCHANGE_NO_WAIT)
                break;
#endif
                if ((unsigned)__builtin_amdgcn_readfirstlane(__hip_atomic_load(cnt + 64 * u.pm, __ATOMIC_RELAXED, __HIP_MEMORY_SCOPE_AGENT)) >= want) break;
                if (__builtin_amdgcn_s_memrealtime() - t0 > 2000000ull) {
                    if (lane == 0) { unsigned expect = 0u; __hip_atomic_compare_exchange_strong(tmo + 1, &expect, code | (unsigned)(u.pm & 0xff), __ATOMIC_RELAXED, __ATOMIC_RELAXED, __HIP_MEMORY_SCOPE_AGENT);
                                     __hip_atomic_store(tmo, 1u, __ATOMIC_RELAXED, __HIP_MEMORY_SCOPE_AGENT); }
                    dead = true; break; }
                __builtin_amdgcn_s_sleep(2);
            }
            __builtin_amdgcn_fence(__ATOMIC_ACQUIRE, "agent");
            if (lane == 0) flag[0] = dead ? 1u : 0u;
        }
        asm volatile("s_waitcnt vmcnt(0) lgkmcnt(0)" ::: "memory"); __builtin_amdgcn_s_barrier(); asm volatile("" ::: "memory");
        const bool bad = flag[0] != 0u;
        if (lane < 32) {
            const unsigned long long* slot = (const unsigned long long*)xbuf + (size_t)(u.pm * BM + row) * 4; float mt[4], m2[4]; float ms = 0.f;
#pragma unroll
            for (int t = 0; t < 4; ++t) { if (t < ntn) { const unsigned long long w = __hip_atomic_load(slot + t, __ATOMIC_RELAXED, __HIP_MEMORY_SCOPE_AGENT); mt[t] = __uint_as_float((unsigned)w); m2[t] = __uint_as_float((unsigned)(w >> 32)); } else { mt[t] = 0.f; m2[t] = 0.f; } ms += mt[t]; }
            const float mean = ms / (float)ntn; float q = 0.f;
#pragma unroll
            for (int t = 0; t < 4; ++t) if (t < ntn) { const float dm = mt[t] - mean; q += m2[t] + 256.0f * dm * dm; }
            S[row] = (f32x2v){mean, 1.0f / sqrtf(q / (256.0f * (float)ntn) + eps)};
        }
        asm volatile("s_waitcnt lgkmcnt(0)" ::: "memory"); __builtin_amdgcn_s_barrier(); asm volatile("" ::: "memory");
        return bad;
    }
};
struct EpiLnRes {
    static constexpr bool PERM = false, AFTER_DRAIN = true;
    const float* base; float* out; int ldc; const float* bias; PanelStats st; unsigned poison;
    __device__ __forceinline__ void fused(f32x4 (&acc)[2][2][4][2], const Unit& u, int wr, int wc, int fr, int fq, PG8_LAS unsigned char* lds, int wid, int lane) const {
        typedef float f32x2v __attribute__((ext_vector_type(2)));
        const PG8_LAS f32x2v* S = (const PG8_LAS f32x2v*)(lds + 8192);
        const int col0 = u.pn * BM + wc * 32 + 4 * fq;
#pragma unroll
        for (int bj = 0; bj < 2; ++bj)
#pragma unroll
            for (int n = 0; n < 2; ++n) { const f32x4 bv = bias ? *(const f32x4*)(bias + col0 + bj * HALF + n * 16) : (f32x4){0.f, 0.f, 0.f, 0.f};
#pragma unroll
                for (int ai = 0; ai < 2; ++ai)
#pragma unroll
                    for (int m = 0; m < 4; ++m) acc[ai][bj][m][n] += bv; }
        f32x4 pre[4][2][2];
#pragma unroll
        for (int m = 0; m < 4; ++m) { const size_t off = (size_t)(u.pm * BM + wr * 64 + m * 16 + fr) * ldc + col0;
#pragma unroll
            for (int bj = 0; bj < 2; ++bj)
#pragma unroll
                for (int n = 0; n < 2; ++n) pre[m][bj][n] = *(const f32x4*)(base + off + bj * HALF + n * 16); }
        const bool bad = st.run(acc, u, wr, wc, fr, fq, lds, wid, lane) || poison != 0u;
        const float qnan = __builtin_nanf("");
#pragma unroll
        for (int ai = 0; ai < 2; ++ai)
#pragma unroll
            for (int m = 0; m < 4; ++m) { const int r = ai * HALF + wr * 64 + m * 16 + fr; const f32x2v sr = S[r]; const size_t off = (size_t)(u.pm * BM + r) * ldc + col0;
#pragma unroll
                for (int bj = 0; bj < 2; ++bj)
#pragma unroll
                    for (int n = 0; n < 2; ++n) { const f32x4 bs = ai == 0 ? pre[m][bj][n] : *(const f32x4*)(base + off + bj * HALF + n * 16); f32x4 o = bs + (acc[ai][bj][m][n] - sr.x) * sr.y;
                        if (bad) o = (f32x4){qnan, qnan, qnan, qnan}; *(f32x4*)(out + off + bj * HALF + n * 16) = o; }
                if (m & 1) asm volatile("" ::: "memory"); }
    }
};
struct EpiLnResLn {
    static constexpr bool PERM = false, AFTER_DRAIN = true;
    const float* base; float* out; bf16_t* xn; int ldc; const float* bias; PanelStats st1, st2; unsigned poison;
    __device__ __forceinline__ void fused(f32x4 (&acc)[2][2][4][2], const Unit& u, int wr, int wc, int fr, int fq, PG8_LAS unsigned char* lds, int wid, int lane) const {
        typedef float f32x2v __attribute__((ext_vector_type(2))); typedef unsigned u32x2v __attribute__((ext_vector_type(2)));
        const PG8_LAS f32x2v* S = (const PG8_LAS f32x2v*)(lds + 8192);
        const int col0 = u.pn * BM + wc * 32 + 4 * fq;
#pragma unroll
        for (int bj = 0; bj < 2; ++bj)
#pragma unroll
            for (int n = 0; n < 2; ++n) { const f32x4 bv = bias ? *(const f32x4*)(bias + col0 + bj * HALF + n * 16) : (f32x4){0.f, 0.f, 0.f, 0.f};
#pragma unroll
                for (int ai = 0; ai < 2; ++ai)
#pragma unroll
                    for (int m = 0; m < 4; ++m) acc[ai][bj][m][n] += bv; }
        bool bad = st1.run(acc, u, wr, wc, fr, fq, lds, wid, lane) || poison != 0u;
        const float qnan = __builtin_nanf("");
#pragma unroll
        for (int ai = 0; ai < 2; ++ai)
#pragma unroll
            for (int m = 0; m < 4; ++m) { const int r = ai * HALF + wr * 64 + m * 16 + fr; const f32x2v sr = S[r]; const size_t off = (size_t)(u.pm * BM + r) * ldc + col0;
#pragma unroll
                for (int bj = 0; bj < 2; ++bj)
#pragma unroll
                    for (int n = 0; n < 2; ++n) { const f32x4 bs = *(const f32x4*)(base + off + bj * HALF + n * 16); acc[ai][bj][m][n] = bs + (acc[ai][bj][m][n] - sr.x) * sr.y; }
                asm volatile("" : "+v"(acc[ai][0][m][0]), "+v"(acc[ai][0][m][1]), "+v"(acc[ai][1][m][0]), "+v"(acc[ai][1][m][1]));
                if (m & 1) asm volatile("" ::: "memory"); }
        const bool bad1 = bad;
        bad = st2.run(acc, u, wr, wc, fr, fq, lds, wid, lane) || bad;
#pragma unroll
        for (int ai = 0; ai < 2; ++ai)
#pragma unroll
            for (int m = 0; m < 4; ++m) { const int r = ai * HALF + wr * 64 + m * 16 + fr; const f32x2v sr = S[r]; const size_t off = (size_t)(u.pm * BM + r) * ldc + col0;
#pragma unroll
                for (int bj = 0; bj < 2; ++bj)
#pragma unroll
                    for (int n = 0; n < 2; ++n) { const f32x4 x1 = acc[ai][bj][m][n]; *(f32x4*)(out + off + bj * HALF + n * 16) = bad1 ? (f32x4){qnan, qnan, qnan, qnan} : x1;
                        const f32x4 o = (x1 - sr.x) * sr.y; u32x2v w; w.x = cvt_pk_bf16(o[0], o[1]); w.y = cvt_pk_bf16(o[2], o[3]);
                        if (bad) { w.x = 0x7fc07fc0u; w.y = 0x7fc07fc0u; } *(u32x2v*)(xn + off + bj * HALF + n * 16) = w; }
                asm volatile("" ::: "memory"); }
    }
};

template <class Epi, class Sched, bool ALIGN_EPI = false, bool SP2 = false>
__device__ __forceinline__ void gemm_phase(PG8_LAS unsigned char* lds, const Gemm g, const Sched& S, const Epi& E) {
    const int tid = threadIdx.x, wid = __builtin_amdgcn_readfirstlane(tid >> 6), lane = tid & 63, wr = wid >> 2, wc = wid & 3, fr = lane & 15, fq = lane >> 4;
    const int K = g.K, nt = K / BK;
    unsigned voffA[2], voffB[2];
#pragma unroll
    for (int i = 0; i < 2; ++i) { int R, C; stage_rc(tid * 16 + i * 8192, R, C); const int Rb = Epi::PERM ? ((R & ~31) + perm32(R & 31)) : R;
        voffA[i] = (unsigned)(R * K + C) * 2u; voffB[i] = (unsigned)(Rb * K + C) * 2u; }
    const size_t kstep = (size_t)(BK * 2);
    const size_t hstep = (size_t)HALF * K * 2;
    const size_t tstep = 2 * hstep;
    const unsigned ldsw = (unsigned)wid * 1024u;
    const int aoff = lds_byte(wr * 64 + fr, fq * 8), boff = lds_byte(wc * 32 + fr, fq * 8);
#define PG8_SA(b, h) (((b) * 2 + (h)) * HTB)
#define PG8_SB(b, h) ((4 + (b) * 2 + (h)) * HTB)
#define PG8_STAGE(bufoff, gbase, voff) do { _Pragma("unroll") for (int _i = 0; _i < 2; ++_i) \
        __builtin_amdgcn_global_load_lds((const unsigned*)((const char*)(gbase) + (voff)[_i]), (PG8_LAS unsigned*)(lds + (bufoff) + ldsw + _i * 8192), 16, 0, 0); } while (0)
#define PG8_LDA(dst, b, h) do { _Pragma("unroll") for (int m = 0; m < 4; ++m) _Pragma("unroll") for (int k = 0; k < 2; ++k) dst[m][k] = *(const PG8_LAS bf16x8*)(lds + PG8_SA(b, h) + aoff + m * 2048 + k * 1024); } while (0)
#define PG8_LDB(dst, b, h) do { _Pragma("unroll") for (int n = 0; n < 2; ++n) _Pragma("unroll") for (int k = 0; k < 2; ++k) dst[n][k] = *(const PG8_LAS bf16x8*)(lds + PG8_SB(b, h) + boff + n * 2048 + k * 1024); } while (0)
#define PG8_MMA(ai, bj, At, Bt) do { __builtin_amdgcn_s_setprio(1); _Pragma("unroll") for (int m = 0; m < 4; ++m) _Pragma("unroll") for (int n = 0; n < 2; ++n) _Pragma("unroll") for (int k = 0; k < 2; ++k) \
        acc[ai][bj][m][n] = __builtin_amdgcn_mfma_f32_16x16x32_bf16(Bt[n][k], At[m][k], acc[ai][bj][m][n], 0, 0, 0); __builtin_amdgcn_s_setprio(0); } while (0)
#define PG8_WAIT_V(n) asm volatile("s_waitcnt vmcnt(" #n ")" ::: "memory")
#define PG8_WAIT_L(n) asm volatile("s_waitcnt lgkmcnt(" #n ")" ::: "memory")
#define PG8_BAR __builtin_amdgcn_s_barrier()
#define PG8_SCHED __builtin_amdgcn_sched_barrier(0)
    Unit cur, nxt; int ui = 0;
    if (!S.next(0, cur)) return;
    f32x4 acc[2][2][4][2];
#pragma unroll
    for (int a = 0; a < 2; ++a)
#pragma unroll
        for (int b = 0; b < 2; ++b)
#pragma unroll
            for (int m = 0; m < 4; ++m)
#pragma unroll
                for (int n = 0; n < 2; ++n) acc[a][b][m][n] = (f32x4){0.f, 0.f, 0.f, 0.f};
    bf16x8 At[4][2], B0[2][2], B1[2][2];
    const char* cA = (const char*)g.A + (size_t)cur.pm * tstep; const char* cB = (const char*)g.Bt + (size_t)cur.pn * tstep;
    S.a_ready(cur);
    if constexpr (SP2) {
        PG8_STAGE(PG8_SB(0, 0), cB, voffB); PG8_STAGE(PG8_SB(0, 1), cB + hstep, voffB); PG8_STAGE(PG8_SA(0, 0), cA, voffA); PG8_STAGE(PG8_SA(0, 1), cA + hstep, voffA);
        if (wr == 1) PG8_BAR;
        PG8_WAIT_V(2); PG8_BAR;
        PG8_STAGE(PG8_SB(1, 0), cB + kstep, voffB); PG8_STAGE(PG8_SA(1, 0), cA + kstep, voffA); PG8_STAGE(PG8_SB(1, 1), cB + hstep + kstep, voffB);
        PG8_WAIT_V(6); PG8_BAR;
    } else {
        PG8_STAGE(PG8_SB(0, 0), cB, voffB); PG8_STAGE(PG8_SA(0, 0), cA, voffA); PG8_STAGE(PG8_SB(0, 1), cB + hstep, voffB); PG8_STAGE(PG8_SA(0, 1), cA + hstep, voffA);
        if (wr == 1) PG8_BAR;
        PG8_WAIT_V(4); PG8_BAR;
        PG8_STAGE(PG8_SB(1, 0), cB + kstep, voffB); PG8_STAGE(PG8_SA(1, 0), cA + kstep, voffA); PG8_STAGE(PG8_SB(1, 1), cB + hstep + kstep, voffB);
        PG8_WAIT_V(6); PG8_BAR;
    }
    for (;;) {
        const bool has_next = S.next(ui + 1, nxt);
        const char* nA = has_next ? (const char*)g.A + (size_t)nxt.pm * tstep : cA; const char* nB = has_next ? (const char*)g.Bt + (size_t)nxt.pn * tstep : cB;
        for (int t = 0; t < nt; t += 2) {
            const bool last = (t == nt - 2);
            const char* a1 = cA + (size_t)(t + 1) * kstep;
            const char* a2 = last ? nA : cA + (size_t)(t + 2) * kstep; const char* b2 = last ? nB : cB + (size_t)(t + 2) * kstep;
            const char* a3 = a2 + kstep; const char* b3 = b2 + kstep;
            if (last && has_next) S.a_ready(nxt);
            if constexpr (SP2) {
            PG8_LDB(B0, 0, 0); PG8_LDB(B1, 0, 1); PG8_SCHED; PG8_LDA(At, 0, 0); PG8_STAGE(PG8_SA(1, 1), a1 + hstep, voffA);
            PG8_WAIT_V(8); PG8_WAIT_L(0); PG8_BAR; PG8_MMA(0, 0, At, B0); PG8_MMA(0, 1, At, B1); PG8_BAR; PG8_SCHED;
            PG8_LDA(At, 0, 1); PG8_STAGE(PG8_SB(0, 0), b2, voffB); PG8_STAGE(PG8_SB(0, 1), b2 + hstep, voffB); PG8_STAGE(PG8_SA(0, 0), a2, voffA);
            PG8_WAIT_V(8); PG8_WAIT_L(0); PG8_BAR; PG8_MMA(1, 0, At, B0); PG8_MMA(1, 1, At, B1); PG8_BAR; PG8_SCHED;
            PG8_LDB(B0, 1, 0); PG8_LDB(B1, 1, 1); PG8_SCHED; PG8_LDA(At, 1, 0); PG8_STAGE(PG8_SA(0, 1), a2 + hstep, voffA);
            PG8_WAIT_V(8); PG8_WAIT_L(0); PG8_BAR; PG8_MMA(0, 0, At, B0); PG8_MMA(0, 1, At, B1); PG8_BAR; PG8_SCHED;
            PG8_LDA(At, 1, 1); PG8_STAGE(PG8_SB(1, 0), b3, voffB); PG8_STAGE(PG8_SB(1, 1), b3 + hstep, voffB); PG8_STAGE(PG8_SA(1, 0), a3, voffA);
            PG8_WAIT_V(8); PG8_WAIT_L(0); PG8_BAR; PG8_MMA(1, 0, At, B0); PG8_MMA(1, 1, At, B1); PG8_BAR; PG8_SCHED;
            } else {
            PG8_LDB(B0, 0, 0); PG8_SCHED; PG8_LDA(At, 0, 0); PG8_STAGE(PG8_SA(1, 1), a1 + hstep, voffA);
            PG8_WAIT_L(8); PG8_BAR; PG8_WAIT_L(0); PG8_MMA(0, 0, At, B0); PG8_BAR; PG8_SCHED;
            PG8_LDB(B1, 0, 1); PG8_STAGE(PG8_SB(0, 0), b2, voffB);
            PG8_BAR; PG8_WAIT_L(0); PG8_MMA(0, 1, At, B1); PG8_BAR;
            PG8_LDA(At, 0, 1); PG8_STAGE(PG8_SA(0, 0), a2, voffA);
            PG8_BAR; PG8_WAIT_L(0); PG8_MMA(1, 0, At, B0); PG8_BAR; PG8_SCHED;
            PG8_STAGE(PG8_SB(0, 1), b2 + hstep, voffB);
            PG8_WAIT_V(6); PG8_BAR; PG8_MMA(1, 1, At, B1); PG8_BAR;
            PG8_LDB(B0, 1, 0); PG8_SCHED; PG8_LDA(At, 1, 0); PG8_STAGE(PG8_SA(0, 1), a2 + hstep, voffA);
            PG8_WAIT_L(8); PG8_BAR; PG8_WAIT_L(0); PG8_MMA(0, 0, At, B0); PG8_BAR; PG8_SCHED;
            PG8_LDB(B1, 1, 1); PG8_STAGE(PG8_SB(1, 0), b3, voffB);
            PG8_BAR; PG8_WAIT_L(0); PG8_MMA(0, 1, At, B1); PG8_BAR;
            PG8_LDA(At, 1, 1); PG8_STAGE(PG8_SA(1, 0), a3, voffA);
            PG8_BAR; PG8_WAIT_L(0); PG8_MMA(1, 0, At, B0); PG8_BAR; PG8_SCHED;
            PG8_STAGE(PG8_SB(1, 1), b3 + hstep, voffB);
            PG8_WAIT_V(6); PG8_BAR; PG8_MMA(1, 1, At, B1); PG8_BAR;
            }
        }
        if constexpr (ALIGN_EPI) { if (wr == 0) PG8_BAR; }
        if constexpr (!Epi::AFTER_DRAIN) { E(acc, cur, wr, wc, fr, fq); S.done(cur); }
        if (!has_next) break;
#pragma unroll
        for (int a = 0; a < 2; ++a)
#pragma unroll
            for (int b = 0; b < 2; ++b)
#pragma unroll
                for (int m = 0; m < 4; ++m)
#pragma unroll
                    for (int n = 0; n < 2; ++n) acc[a][b][m][n] = (f32x4){0.f, 0.f, 0.f, 0.f};
        cur = nxt; cA = nA; cB = nB; ++ui;
        if constexpr (ALIGN_EPI) { if (wr == 1) PG8_BAR; }
    }
    PG8_WAIT_V(0);
    if constexpr (!ALIGN_EPI) { if (wr == 0) PG8_BAR; }
    PG8_BAR;
    if constexpr (Epi::AFTER_DRAIN) { E.fused(acc, cur, wr, wc, fr, fq, lds, wid, lane); S.done(cur); }
#undef PG8_SA
#undef PG8_SB
#undef PG8_STAGE
#undef PG8_LDA
#undef PG8_LDB
#undef PG8_MMA
#undef PG8_WAIT_V
#undef PG8_WAIT_L
#undef PG8_BAR
#undef PG8_SCHED
}
}
#define XB_TMO      128
#define XB_XCNT(j)  (256  + 64 * (j))
#define XB_XSUB(j)  (1280 + 64 * (j))
#define XB_XGEN(j)  (2304 + 64 * (j))
#define XB_TOP      3328
#define XB_TOPGEN   3392
#define XCD_BAR_WORDS 3456
#define XB_SPIN_CAP (1u << 18)

__device__ __forceinline__ unsigned xb_ld(unsigned* p)              { return __hip_atomic_load(p, __ATOMIC_RELAXED, __HIP_MEMORY_SCOPE_AGENT); }
__device__ __forceinline__ unsigned xb_add(unsigned* p, unsigned v) { return __hip_atomic_fetch_add(p, v, __ATOMIC_RELAXED, __HIP_MEMORY_SCOPE_AGENT); }
__device__ __forceinline__ unsigned xb_xcc_id() { return (unsigned)__builtin_amdgcn_s_getreg((3 << 11) | 20) & 0xFu; }
#define XB_SPIN(cond, bar) do { unsigned _sp = 0; while (cond) { __builtin_amdgcn_s_sleep(1); \
    if ((++_sp & 255u) == 0u) { if (xb_ld(&(bar)[XB_TMO])) break; if (_sp > XB_SPIN_CAP) { atomicAdd(&(bar)[XB_TMO], 1u); break; } } } } while (0)

struct XcdBarrier {
    unsigned* bar; unsigned x;
    volatile LAS unsigned* st;
};

__device__ __forceinline__ XcdBarrier xcd_barrier_post(unsigned* bar, volatile LAS unsigned* st) {
    XcdBarrier b; b.bar = bar; b.x = xb_xcc_id(); b.st = st;
    if (threadIdx.x == 0) (void)xb_add(&bar[XB_XCNT(b.x)], 1u);
    return b;
}
__device__ __forceinline__ void xcd_barrier_complete(unsigned* bar, unsigned x, unsigned& nloc, unsigned& nx) {
    const unsigned G = gridDim.x * gridDim.y * gridDim.z;
    unsigned sum, cnt, mine, sp = 0u;
    for (;;) {
        sum = 0u; cnt = 0u; mine = 0u;
#pragma unroll
        for (unsigned j = 0; j < 16; ++j) { const unsigned c = xb_ld(&bar[XB_XCNT(j)]); sum += c; cnt += (c > 0u) ? 1u : 0u; mine = (j == x) ? c : mine; }
        if (sum == G) break;
        __builtin_amdgcn_s_sleep(1);
        if ((++sp & 255u) == 0u) { if (xb_ld(&bar[XB_TMO])) break; if (sp > XB_SPIN_CAP) { atomicAdd(&bar[XB_TMO], 1u); break; } }
    }
    nloc = mine > 0u ? mine : 1u; nx = cnt > 0u ? cnt : 1u;
}

__device__ __forceinline__ void xcd_barrier(const XcdBarrier& b) {
    asm volatile("s_waitcnt vmcnt(0)" ::: "memory");
    __syncthreads();
    if (threadIdx.x == 0) {
        unsigned* bar = b.bar;
        __builtin_amdgcn_s_waitcnt(0);
        unsigned nloc = b.st[0], nx = b.st[1];
        if (nloc == 0u) { xcd_barrier_complete(bar, b.x, nloc, nx); b.st[0] = nloc; b.st[1] = nx; }
        const unsigned old = xb_add(&bar[XB_XSUB(b.x)], 1u);
        const unsigned gen = old / nloc;
        if (old + 1u == (gen + 1u) * nloc) {
            __builtin_amdgcn_fence(__ATOMIC_RELEASE, "agent");
            asm volatile("s_waitcnt vmcnt(0)" ::: "memory");
            const unsigned og = xb_add(&bar[XB_TOP], 1u);
            const unsigned tg = og / nx;
            if (og + 1u == (tg + 1u) * nx) xb_add(&bar[XB_TOPGEN], 1u);
            else XB_SPIN(xb_ld(&bar[XB_TOPGEN]) == tg, bar);
            __builtin_amdgcn_fence(__ATOMIC_ACQUIRE, "agent");
            xb_add(&bar[XB_XGEN(b.x)], 1u);
            asm volatile("s_waitcnt vmcnt(0)" ::: "memory");
        } else {
            XB_SPIN(xb_ld(&bar[XB_XGEN(b.x)]) == gen, bar);
            __builtin_amdgcn_fence(__ATOMIC_ACQUIRE, "agent");
            asm volatile("s_waitcnt vmcnt(0)" ::: "memory");
        }
    }
    __syncthreads();
}
struct Frame {
    LAS unsigned char* lds;
    volatile LAS unsigned* MISC;
    gu32* ctl;
    int tid, lane, wave;
    int vcu, G;
};
__device__ __forceinline__ float wave_sum(float v) {
#pragma unroll
    for (int o = 1; o < 64; o <<= 1) v += __shfl_xor(v, o);
    return v;
}
__device__ __forceinline__ float rdlane(float v, int l) { return __builtin_bit_cast(float, __builtin_amdgcn_readlane(__builtin_bit_cast(int, v), l)); }
__device__ __forceinline__ float silu_f(float x) { return x / (1.f + __expf(-x)); }

__device__ __forceinline__ int win_src(int n) {
    if (n < 1024) { const int seg = n >> 9, c = n & 511, head = c >> 6, cc = c & 63; return seg * 512 + head * 64 + (cc >> 1) + 32 * (cc & 1); }
    if (n < 1536) return n;
    if (n < 1792) { const int c = n - 1536, head = c >> 5, cc = c & 31; return 1536 + head * 32 + (cc >> 1) + 16 * (cc & 1); }
    if (n < 2048) return 1832 + (n - 1792);
    if (n < 2304) return 2088 + (n - 2048);
    if (n < 2816) return 2344 + (n - 2304);
    if (n < 3328) return 2856 + (n - 2816);
    if (n < 3360) { const int cc = n - 3328; return 1792 + (cc >> 1) + 16 * (cc & 1); }
    if (n < 3368) return 1824 + (n - 3360);
    if (n < 3384) return n;
    return -1;
}
__device__ __forceinline__ int ei_src(int n) { return (n & 4) ? 512 + 4 * (n >> 3) + (n & 3) : 4 * (n >> 3) + (n & 3); }
template <int MODE> __device__ __forceinline__ void p0_transpose_item(const float* W, int K, int N, bf16* WT, LAS float* scr, int kb, int nb, int lane) {
    const int k0 = 64 * kb, n0 = 32 * nb;
    int sc = n0 + (lane & 31); if (MODE == 1) sc = win_src(sc); if (MODE == 2) sc = ei_src(sc);
#pragma unroll 8
    for (int i = 0; i < 32; ++i) { const int kk = 2 * i + (lane >> 5); scr[kk * 33 + (lane & 31)] = (sc >= 0) ? W[(size_t)(k0 + kk) * N + sc] : 0.f; }
    LDS_WAIT(); asm volatile("" ::: "memory");
    const int c = lane & 7;
#pragma unroll
    for (int j = 0; j < 4; ++j) { const int n = (lane >> 3) + 8 * j; const LAS float* s = scr + (8 * c) * 33 + n;
        v4u o; o.x = pk2(s[0 * 33], s[1 * 33]); o.y = pk2(s[2 * 33], s[3 * 33]); o.z = pk2(s[4 * 33], s[5 * 33]); o.w = pk2(s[6 * 33], s[7 * 33]);
        *(GAS v4u*)(WT + (size_t)(n0 + n) * K + k0 + 8 * c) = o; }
    LDS_WAIT(); asm volatile("" ::: "memory");
}
__device__ __forceinline__ void p0_prologue(Frame& F, const Args& a) {
    unsigned char* ws = a.ws;
    LAS float* scr = (LAS float*)(F.lds + RING_OFF + F.wave * 16384);
    const int gw = F.vcu * NWAVES + F.wave, NGW = F.G * NWAVES;
    constexpr int I_IN = 16 * (NPROJ / 32), I_O = 16 * 32, I_EI = 32 * 16 * 32, I_EO = 32 * 8 * 32;
    constexpr int NITEMS = I_IN + I_O + I_EI + I_EO;
    for (int it = gw; it < NITEMS; it += NGW) {
        int r = it;
        if (r < I_IN) { p0_transpose_item<1>(a.in[1], D, IN_W, (bf16*)(ws + WS_WIN), scr, r / (NPROJ / 32), r % (NPROJ / 32), F.lane); continue; } r -= I_IN;
        if (r < I_O) { p0_transpose_item<0>(a.in[5], D, D, (bf16*)(ws + WS_WO), scr, r / 32, r % 32, F.lane); continue; } r -= I_O;
        if (r < I_EI) { const int e = r / 512, q = r % 512; p0_transpose_item<2>(a.in[12] + (size_t)e * 1024 * 1024, 1024, 1024, (bf16*)(ws + WS_WEI) + (size_t)e * 1024 * 1024, scr, q / 32, q % 32, F.lane); continue; } r -= I_EI;
        { const int e = r / 256, q = r % 256; p0_transpose_item<0>(a.in[13] + (size_t)e * 512 * 1024, 512, 1024, (bf16*)(ws + WS_WEO) + (size_t)e * 1024 * 512, scr, q / 32, q % 32, F.lane); }
    }
    for (int m = gw; m < M; m += NGW) {
        const GAS f32x4* xr = (const GAS f32x4*)(a.in[0] + (size_t)m * D) + F.lane;
        GAS v2u* o8 = (GAS v2u*)((bf16*)(ws + WS_XB) + (size_t)m * D) + F.lane;
#pragma unroll
        for (int j = 0; j < 4; ++j) { const f32x4 v = xr[64 * j]; v2u w; w.x = pk2(v.x, v.y); w.y = pk2(v.z, v.w); o8[64 * j] = w; }
    }
    const int gt = F.vcu * (NWAVES * 64) + F.tid, NGT = F.G * NWAVES * 64;
    for (int i = gt; i < T * 48; i += NGT) {
        const int pos = i / 48, jj = i % 48; const bool big = jj < 32; const int j = big ? jj : jj - 32;
        const double r = big ? 0.74989420933245582730   : 0.56234132519034908039  ;
        double inv = 1.0; for (int k = 0; k < j; ++k) inv *= r;
        const double rev = (double)pos * inv * 0.15915494309189533577; const float f = (float)(rev - __builtin_floor(rev));
        const float c = __builtin_amdgcn_cosf(f), s = __builtin_amdgcn_sinf(f);
        if (big) { ((float*)(ws + WS_COS64))[pos * 32 + j] = c; ((float*)(ws + WS_SIN64))[pos * 32 + j] = s; }
        else { ((float*)(ws + WS_COS32))[pos * 16 + j] = c; ((float*)(ws + WS_SIN32))[pos * 16 + j] = s; }
    }
}
struct EpiProj {
    static constexpr bool PERM = true, AFTER_DRAIN = false;
    unsigned char* ws;
    static __device__ __forceinline__ void rope4(f32x4& v0, f32x4& v1, const f32x4 c, const f32x4 s) {
        const f32x4 a = v0, b = v1;
        v0[0] = a[0] * c[0] - a[1] * s[0]; v0[1] = a[1] * c[0] + a[0] * s[0];
        v0[2] = a[2] * c[1] - a[3] * s[1]; v0[3] = a[3] * c[1] + a[2] * s[1];
        v1[0] = b[0] * c[2] - b[1] * s[2]; v1[1] = b[1] * c[2] + b[0] * s[2];
        v1[2] = b[2] * c[3] - b[3] * s[3]; v1[3] = b[3] * c[3] + b[2] * s[3];
    }
    template <int SEG> __device__ __forceinline__ void emit(const f32x4 (&acc)[2][2][4][2], const pg8::Unit& u, int wr, int wc, int fr, int fq) const {
        const int row0 = u.pm * 256 + wr * 64 + fr;
#pragma unroll
        for (int ai = 0; ai < 2; ++ai)
#pragma unroll
            for (int m = 0; m < 4; ++m) {
                const int r = row0 + ai * 128 + m * 16, pos = r & (T - 1);
#pragma unroll
                for (int bj = 0; bj < 2; ++bj) {
                    const int cg = u.pn * 256 + bj * 128 + wc * 32 + 8 * fq;
                    f32x4 v0 = acc[ai][bj][m][0], v1 = acc[ai][bj][m][1];
                    if (SEG == 0 || SEG == 1) {
                        const int j0 = (cg & 63) >> 1;
                        const f32x4 c = *(const f32x4*)((const float*)(ws + WS_COS64) + pos * 32 + j0), s = *(const f32x4*)((const float*)(ws + WS_SIN64) + pos * 32 + j0);
                        rope4(v0, v1, c, s);
                        if (SEG == 0) { v0 = v0 * QK_C2; v1 = v1 * QK_C2; }
                        v4u w; w.x = pk2(v0[0], v0[1]); w.y = pk2(v0[2], v0[3]); w.z = pk2(v1[0], v1[1]); w.w = pk2(v1[2], v1[3]);
                        *(v4u*)((bf16*)(ws + (SEG == 0 ? WS_AQ : WS_AK)) + (size_t)r * 512 + (cg & 511)) = w;
                    } else if (SEG == 2 || SEG == 6 || SEG == 7) {
                        const size_t base = SEG == 2 ? WS_AV : (SEG == 6 ? WS_BV : WS_BR); const int c0 = SEG == 2 ? 1024 : (SEG == 6 ? 2304 : 2816);
                        v4u w; w.x = pk2(v0[0], v0[1]); w.y = pk2(v0[2], v0[3]); w.z = pk2(v1[0], v1[1]); w.w = pk2(v1[2], v1[3]);
                        *(v4u*)((bf16*)(ws + base) + (size_t)r * 512 + (cg - c0)) = w;
                    } else if (SEG == 3) {
                        const int j0 = (cg & 31) >> 1;
                        const f32x4 c = *(const f32x4*)((const float*)(ws + WS_COS32) + pos * 16 + j0), s = *(const f32x4*)((const float*)(ws + WS_SIN32) + pos * 16 + j0);
                        rope4(v0, v1, c, s);
                        v4u w; w.x = pkh2(v0[0], v0[1]); w.y = pkh2(v0[2], v0[3]); w.z = pkh2(v1[0], v1[1]); w.w = pkh2(v1[2], v1[3]);
                        *(v4u*)((unsigned short*)(ws + WS_IQ) + (size_t)r * 256 + (cg - 1536)) = w;
                    } else if (SEG == 4 || SEG == 5) {
                        if (SEG == 4) { v0 = v0 * 0.125f; v1 = v1 * 0.125f; }
                        v4u w; w.x = pk2(v0[0], v0[1]); w.y = pk2(v0[2], v0[3]); w.z = pk2(v1[0], v1[1]); w.w = pk2(v1[2], v1[3]);
                        *(v4u*)((bf16*)(ws + (SEG == 4 ? WS_BQ : WS_BK)) + (size_t)r * 256 + (cg - (SEG == 4 ? 1792 : 2048))) = w;
                    } else {
                        const int tc = cg - 3328;
                        if (tc < 32) {
                            const int j0 = tc >> 1;
                            const f32x4 c = *(const f32x4*)((const float*)(ws + WS_COS32) + pos * 16 + j0), s = *(const f32x4*)((const float*)(ws + WS_SIN32) + pos * 16 + j0);
                            rope4(v0, v1, c, s);
                            v4u w; w.x = pkh2(v0[0], v0[1]); w.y = pkh2(v0[2], v0[3]); w.z = pkh2(v1[0], v1[1]); w.w = pkh2(v1[2], v1[3]);
                            *(v4u*)((unsigned short*)(ws + WS_IK) + (size_t)r * 32 + tc) = w;
                        } else if (tc < 40) {
                            float* p = (float*)(ws + WS_IW) + (size_t)r * 8; *(f32x4*)p = v0 * IDX_SCALE; *(f32x4*)(p + 4) = v1 * IDX_SCALE;
                        } else if (tc < 56) {
                            float* p = (float*)(ws + WS_BG) + (size_t)r * 16 + (tc - 40); *(f32x4*)p = v0; *(f32x4*)(p + 4) = v1;
                        }
                    }
                }
            }
    }
    __device__ __forceinline__ void operator()(const f32x4 (&acc)[2][2][4][2], const pg8::Unit& u, int wr, int wc, int fr, int fq) const {
        switch (u.pn) {
            case 0: case 1: emit<0>(acc, u, wr, wc, fr, fq); break;
            case 2: case 3: emit<1>(acc, u, wr, wc, fr, fq); break;
            case 4: case 5: emit<2>(acc, u, wr, wc, fr, fq); break;
            case 6: emit<3>(acc, u, wr, wc, fr, fq); break;
            case 7: emit<4>(acc, u, wr, wc, fr, fq); break;
            case 8: emit<5>(acc, u, wr, wc, fr, fq); break;
            case 9: case 10: emit<6>(acc, u, wr, wc, fr, fq); break;
            case 11: case 12: emit<7>(acc, u, wr, wc, fr, fq); break;
            default: emit<8>(acc, u, wr, wc, fr, fq); break;
        }
    }
};
struct EpiF32 {
    static constexpr bool PERM = false, AFTER_DRAIN = false;
    float* C; int ldc;
    __device__ __forceinline__ void operator()(const f32x4 (&acc)[2][2][4][2], const pg8::Unit& u, int wr, int wc, int fr, int fq) const {
        const int row0 = u.pm * 256 + wr * 64 + fr, col0 = u.pn * 256 + wc * 32 + 4 * fq;
#pragma unroll
        for (int ai = 0; ai < 2; ++ai)
#pragma unroll
            for (int m = 0; m < 4; ++m) { float* rowp = C + (size_t)(row0 + ai * 128 + m * 16) * ldc + col0;
#pragma unroll
                for (int bj = 0; bj < 2; ++bj)
#pragma unroll
                    for (int n = 0; n < 2; ++n) *(f32x4*)(rowp + bj * 128 + n * 16) = acc[ai][bj][m][n]; }
    }
};
constexpr int GL_GT = 0, GL_RS = 2048, GL_QG = 4096, GL_KG = GL_QG + 9216, GL_KD = GL_KG + 9216, GL_V = 32768;
constexpr int GL_S64 = 144, GL_SV = 272;
typedef short v4i16_t __attribute__((ext_vector_type(4)));
__device__ __forceinline__ bf16x8 tr_frag(LAS const unsigned char* img, int stride, int r0a, int r0b, int c0, int lane) {
    const int q = (lane & 15) >> 2, p = lane & 3;
    const s16x4 lo = __builtin_bit_cast(s16x4, __builtin_amdgcn_ds_read_tr16_b64_v4i16((LAS v4i16_t*)(img + (r0a + q) * stride + (c0 + 4 * p) * 2)));
    const s16x4 hi = __builtin_bit_cast(s16x4, __builtin_amdgcn_ds_read_tr16_b64_v4i16((LAS v4i16_t*)(img + (r0b + q) * stride + (c0 + 4 * p) * 2)));
    return (bf16x8){lo[0], lo[1], lo[2], lo[3], hi[0], hi[1], hi[2], hi[3]};
}
__device__ __forceinline__ void gla_gate_unit(const Args& a, int t0, int h, LAS float* GT, int tid, int lane, int g, float (&b)[8], float& blast) {
    const int d = tid & 63;
    const float* Wg = a.in[2]; const float* BG = (const float*)(a.ws + WS_BG);
    float w[16];
#pragma unroll
    for (int r = 0; r < 16; ++r) w[r] = Wg[r * 256 + h * 64 + d];
    const float bias = a.in[3][h * 64 + d];
    const float bv0 = BG[(size_t)(t0 + 8 * g + (lane >> 4)) * 16 + (lane & 15)];
    const float bv1 = BG[(size_t)(t0 + 8 * g + 4 + (lane >> 4)) * 16 + (lane & 15)];
    float run = 0.f;
#pragma unroll
    for (int jj = 0; jj < 8; ++jj) {
        float z = bias;
#pragma unroll
        for (int r = 0; r < 16; ++r) z += rdlane(jj < 4 ? bv0 : bv1, (jj & 3) * 16 + r) * w[r];
        const float la = (fminf(z, 0.f) - log1pf(expf(-fabsf(z)))) * (1.f / 16.f);
        run += la; b[jj] = run;
    }
    GT[g * 64 + d] = run;
    __syncthreads();
    float off = 0.f, tot = 0.f;
#pragma unroll
    for (int gg = 0; gg < 8; ++gg) { const float v = GT[gg * 64 + d]; tot += v; if (gg < g) off += v; }
#pragma unroll
    for (int jj = 0; jj < 8; ++jj) b[jj] += off;
    blast = tot;
}
__device__ __forceinline__ void gla_stage_v(const Args& a, LAS unsigned char* L, int t0, int h, int tid) {
    const bf16* BV = (const bf16*)(a.ws + WS_BV);
#pragma unroll
    for (int i = 0; i < 2; ++i) { const int p = tid + 512 * i, row = p >> 4, cp = p & 15;
        *(LAS v4u*)(L + GL_V + row * GL_SV + cp * 16) = *(const v4u*)(BV + (size_t)(t0 + row) * 512 + h * 128 + cp * 8); }
}
__device__ __forceinline__ void gla_phase_a(Frame& F, const Args& a, float* KVT, float* DEC) {
    LAS unsigned char* L = F.lds + RING_OFF;
    const int tid = F.tid, lane = F.lane, g = F.wave, d = tid & 63, fq = lane >> 4;
    const bf16* BK = (const bf16*)(a.ws + WS_BK);
    for (int u = F.vcu * 8; u < 2048; u += F.G * 8)
        for (int uu = u; uu < u + 8; ++uu) {
            const int h = uu & 3, bn = uu >> 2, t0 = bn * 64;
            float b[8], blast;
            gla_gate_unit(a, t0, h, (LAS float*)(L + GL_GT), tid, lane, g, b, blast);
#pragma unroll
            for (int jj = 0; jj < 8; ++jj) { const int j = 8 * g + jj;
                const float kv = bf2f(BK[(size_t)(t0 + j) * 256 + h * 64 + d]);
                *(LAS unsigned short*)(L + GL_KD + j * GL_S64 + d * 2) = (unsigned short)f2bf(kv * __expf(blast - b[jj])); }
            gla_stage_v(a, L, t0, h, tid);
            if (g == 0) DEC[uu * 64 + d] = __expf(blast);
            __syncthreads();
            const int vt = g;
            const bf16x8 a0 = tr_frag(L + GL_V, GL_SV, 8 * fq, 8 * fq + 4, 16 * vt, lane), a1 = tr_frag(L + GL_V, GL_SV, 32 + 8 * fq, 36 + 8 * fq, 16 * vt, lane);
#pragma unroll
            for (int dt = 0; dt < 4; ++dt) {
                const bf16x8 b0 = tr_frag(L + GL_KD, GL_S64, 8 * fq, 8 * fq + 4, 16 * dt, lane), b1 = tr_frag(L + GL_KD, GL_S64, 32 + 8 * fq, 36 + 8 * fq, 16 * dt, lane);
                f32x4 acc = {0.f, 0.f, 0.f, 0.f};
                acc = __builtin_amdgcn_mfma_f32_16x16x32_bf16(a0, b0, acc, 0, 0, 0);
                acc = __builtin_amdgcn_mfma_f32_16x16x32_bf16(a1, b1, acc, 0, 0, 0);
#pragma unroll
                for (int r = 0; r < 4; ++r) KVT[(size_t)uu * 8192 + (16 * vt + 4 * fq + r) * 64 + 16 * dt + (lane & 15)] = acc[r];
            }
        }
    __syncthreads();
}
__device__ __forceinline__ void gla_phase_b(Frame& F, const float* KVT, const float* DEC, bf16* SPREV) {
    for (int it = F.vcu; it < 256; it += F.G) {
        const int bh = it >> 4, part = it & 15, idx = part * 512 + F.tid, d = idx & 63, bb = bh >> 2, h = bh & 3;
        float S = 0.f;
        for (int n0 = 0; n0 < NCHUNK; n0 += 8) {
            float kv[8], dc[8];
#pragma unroll
            for (int k = 0; k < 8; ++k) { const int u = (bb * NCHUNK + n0 + k) * 4 + h; kv[k] = KVT[(size_t)u * 8192 + idx]; dc[k] = DEC[u * 64 + d]; }
#pragma unroll
            for (int k = 0; k < 8; ++k) { const int u = (bb * NCHUNK + n0 + k) * 4 + h; SPREV[(size_t)u * 8192 + idx] = (bf16)f2bf(S); S = dc[k] * S + kv[k]; }
        }
    }
}
__device__ __forceinline__ void gla_phase_c(Frame& F, const Args& a, const bf16* SPREV) {
    LAS unsigned char* L = F.lds + RING_OFF;
    const int tid = F.tid, lane = F.lane, g = F.wave, d = tid & 63, fq = lane >> 4, l15 = lane & 15;
    const bf16* BQ = (const bf16*)(a.ws + WS_BQ); const bf16* BK = (const bf16*)(a.ws + WS_BK); const bf16* BR = (const bf16*)(a.ws + WS_BR);
    bf16* Y = (bf16*)(a.ws + WS_Y); const float* gn = a.in[4];
    LAS float* RS = (LAS float*)(L + GL_RS);
    for (int u = F.vcu * 8; u < 2048; u += F.G * 8)
        for (int uu = u; uu < u + 8; ++uu) {
            const int h = uu & 3, bn = uu >> 2, t0 = bn * 64;
            float b[8], blast;
            gla_gate_unit(a, t0, h, (LAS float*)(L + GL_GT), tid, lane, g, b, blast);
#pragma unroll
            for (int jj = 0; jj < 8; ++jj) { const int j = 8 * g + jj;
                const float qv = bf2f(BQ[(size_t)(t0 + j) * 256 + h * 64 + d]), kv = bf2f(BK[(size_t)(t0 + j) * 256 + h * 64 + d]);
                *(LAS unsigned short*)(L + GL_QG + j * GL_S64 + d * 2) = (unsigned short)f2bf(qv * __expf(b[jj]));
                *(LAS unsigned short*)(L + GL_KG + j * GL_S64 + d * 2) = (unsigned short)f2bf(kv * __expf(-b[jj])); }
            gla_stage_v(a, L, t0, h, tid);
            __syncthreads();
            const int it = g & 3, vh = g >> 2;
            bf16x8 qf[2];
#pragma unroll
            for (int s = 0; s < 2; ++s) qf[s] = *(LAS const bf16x8*)(L + GL_QG + (16 * it + l15) * GL_S64 + (32 * s + 8 * fq) * 2);
            f32x4 at[4];
#pragma unroll
            for (int jt = 0; jt < 4; ++jt) {
                f32x4 acc = {0.f, 0.f, 0.f, 0.f};
                if (jt <= it) {
#pragma unroll
                    for (int s = 0; s < 2; ++s) { const bf16x8 kf = *(LAS const bf16x8*)(L + GL_KG + (16 * jt + l15) * GL_S64 + (32 * s + 8 * fq) * 2);
                        acc = __builtin_amdgcn_mfma_f32_16x16x32_bf16(kf, qf[s], acc, 0, 0, 0); }
#pragma unroll
                    for (int r = 0; r < 4; ++r) if (16 * jt + 4 * fq + r > 16 * it + l15) acc[r] = 0.f;
                }
                at[jt] = acc;
            }
            bf16x8 af[2];
#pragma unroll
            for (int s = 0; s < 2; ++s) { v4u w; w.x = pk2(at[2 * s][0], at[2 * s][1]); w.y = pk2(at[2 * s][2], at[2 * s][3]); w.z = pk2(at[2 * s + 1][0], at[2 * s + 1][1]); w.w = pk2(at[2 * s + 1][2], at[2 * s + 1][3]);
                af[s] = __builtin_bit_cast(bf16x8, w); }
            f32x4 o[4]; float ssq = 0.f;
#pragma unroll
            for (int k = 0; k < 4; ++k) { const int vt = 4 * vh + k;
                f32x4 acc = {0.f, 0.f, 0.f, 0.f};
#pragma unroll
                for (int s = 0; s < 2; ++s) { const bf16x8 va = tr_frag(L + GL_V, GL_SV, 32 * s + 4 * fq, 32 * s + 16 + 4 * fq, 16 * vt, lane);
                    acc = __builtin_amdgcn_mfma_f32_16x16x32_bf16(va, af[s], acc, 0, 0, 0); }
#pragma unroll
                for (int s = 0; s < 2; ++s) { const bf16x8 sa = *(const bf16x8*)(SPREV + (size_t)uu * 8192 + (16 * vt + l15) * 64 + 32 * s + 8 * fq);
                    acc = __builtin_amdgcn_mfma_f32_16x16x32_bf16(sa, qf[s], acc, 0, 0, 0); }
                o[k] = acc; ssq += (acc[0] * acc[0] + acc[1] * acc[1]) + (acc[2] * acc[2] + acc[3] * acc[3]);
            }
            ssq += __shfl_xor(ssq, 16); ssq += __shfl_xor(ssq, 32);
            if (fq == 0) RS[vh * 64 + 16 * it + l15] = ssq;
            __syncthreads();
            const float tot = RS[16 * it + l15] + RS[64 + 16 * it + l15];
            const float rstd = 1.f / sqrtf(tot * (1.f / 128.f) + LN_EPS);
            const int tok = t0 + 16 * it + l15;
#pragma unroll
            for (int k = 0; k < 4; ++k) { const int v0 = 16 * (4 * vh + k) + 4 * fq;
                const f32x4 gv = *(const f32x4*)(gn + v0);
                const v2u brw = *(const v2u*)(BR + (size_t)tok * 512 + h * 128 + v0);
                const float r0 = bf2f((unsigned short)(brw.x & 0xffffu)), r1 = bf2f((unsigned short)(brw.x >> 16)), r2 = bf2f((unsigned short)(brw.y & 0xffffu)), r3 = bf2f((unsigned short)(brw.y >> 16));
                v2u w; w.x = pk2(o[k][0] * rstd * gv[0] * silu_f(r0), o[k][1] * rstd * gv[1] * silu_f(r1)); w.y = pk2(o[k][2] * rstd * gv[2] * silu_f(r2), o[k][3] * rstd * gv[3] * silu_f(r3));
                *(v2u*)(Y + (size_t)tok * 1024 + 512 + h * 128 + v0) = w; }
        }
    __syncthreads();
}
__device__ __forceinline__ void ln1_phase(Frame& F, const Args& a, float* H, bf16* HB) {
    const int gw = F.vcu * NWAVES + F.wave, NGW = F.G * NWAVES;
    const float* x = a.in[0]; const float* g1 = a.in[6]; const float* b1 = a.in[7];
    for (int m = gw; m < M; m += NGW) {
        const GAS f32x4* xr = (const GAS f32x4*)(x + (size_t)m * D) + F.lane;
        GAS f32x4* hr = (GAS f32x4*)(H + (size_t)m * D) + F.lane;
        f32x4 v[4]; float s = 0.f;
#pragma unroll
        for (int j = 0; j < 4; ++j) { v[j] = xr[64 * j] * ALPHA + hr[64 * j]; s += (v[j].x + v[j].y) + (v[j].z + v[j].w); }
        const float mean = wave_sum(s) * (1.f / D); float s2 = 0.f;
#pragma unroll
        for (int j = 0; j < 4; ++j) { v[j] = v[j] - mean; s2 += (v[j].x * v[j].x + v[j].y * v[j].y) + (v[j].z * v[j].z + v[j].w * v[j].w); }
        const float rstd = 1.f / sqrtf(wave_sum(s2) * (1.f / D) + LN_EPS);
        GAS v2u* o8 = (GAS v2u*)(HB + (size_t)m * D) + F.lane;
#pragma unroll
        for (int j = 0; j < 4; ++j) { const f32x4 g = ((const GAS f32x4*)g1)[F.lane + 64 * j], b = ((const GAS f32x4*)b1)[F.lane + 64 * j];
            v[j] = v[j] * rstd * g + b; hr[64 * j] = v[j]; v2u w; w.x = pk2(v[j].x, v[j].y); w.y = pk2(v[j].z, v[j].w); o8[64 * j] = w; }
    }
}
__device__ __forceinline__ void ln2_phase(Frame& F, const Args& a, float* H, const bf16* FFN2) {
    const int gw = F.vcu * NWAVES + F.wave, NGW = F.G * NWAVES;
    const float* g2 = a.in[14]; const float* b2 = a.in[15];
    for (int m = gw; m < M; m += NGW) {
        GAS f32x4* hr = (GAS f32x4*)(H + (size_t)m * D) + F.lane;
        f32x4 v[4]; float s = 0.f;
#pragma unroll
        for (int j = 0; j < 4; ++j) { v[j] = hr[64 * j] * ALPHA;
            if (FFN2) { const GAS v2u* f0 = (const GAS v2u*)(FFN2 + (size_t)(2 * m) * D) + F.lane; const GAS v2u* f1 = (const GAS v2u*)(FFN2 + (size_t)(2 * m + 1) * D) + F.lane;
                const v2u p = f0[64 * j], q = f1[64 * j];
                v[j].x += bf2f((unsigned short)(p.x & 0xffffu)) + bf2f((unsigned short)(q.x & 0xffffu)); v[j].y += bf2f((unsigned short)(p.x >> 16)) + bf2f((unsigned short)(q.x >> 16));
                v[j].z += bf2f((unsigned short)(p.y & 0xffffu)) + bf2f((unsigned short)(q.y & 0xffffu)); v[j].w += bf2f((unsigned short)(p.y >> 16)) + bf2f((unsigned short)(q.y >> 16)); }
            s += (v[j].x + v[j].y) + (v[j].z + v[j].w); }
        const float mean = wave_sum(s) * (1.f / D); float s2 = 0.f;
#pragma unroll
        for (int j = 0; j < 4; ++j) { v[j] = v[j] - mean; s2 += (v[j].x * v[j].x + v[j].y * v[j].y) + (v[j].z * v[j].z + v[j].w * v[j].w); }
        const float rstd = 1.f / sqrtf(wave_sum(s2) * (1.f / D) + LN_EPS);
#pragma unroll
        for (int j = 0; j < 4; ++j) { const f32x4 g = ((const GAS f32x4*)g2)[F.lane + 64 * j], b = ((const GAS f32x4*)b2)[F.lane + 64 * j]; hr[64 * j] = v[j] * rstd * g + b; }
    }
}
__device__ __forceinline__ void zero_ya(Frame& F, const Args& a) {
    const int gt = F.vcu * (NWAVES * 64) + F.tid, NGT = F.G * NWAVES * 64;
    bf16* Y = (bf16*)(a.ws + WS_Y);
    for (int i = gt; i < M * 64; i += NGT) { const int r = i >> 6, c = i & 63; *(v4u*)(Y + (size_t)r * 1024 + c * 8) = (v4u){0u, 0u, 0u, 0u}; }
}
constexpr size_t WS_WRH = WS_MOE, WS_WRL = WS_MOE + 128 * 1024, WS_EID = WS_MOE + 512 * 1024, WS_GATE = WS_MOE + 1024 * 1024, WS_CNT = WS_MOE + 1536 * 1024,
                 WS_OFFS = WS_MOE + 1536 * 1024 + 64 * 1024, WS_DEST = WS_MOE + 2048 * 1024, WS_GPOS = WS_MOE + 2560 * 1024;
constexpr int MOE_MAXTILES = 288;
constexpr int TILEE_OFF = MISC_OFF + 256;
__device__ __forceinline__ void p0_router_weights(Frame& F, const Args& a) {
    const int gt = F.vcu * (NWAVES * 64) + F.tid, NGT = F.G * NWAVES * 64;
    bf16* WH = (bf16*)(a.ws + WS_WRH); bf16* WL = (bf16*)(a.ws + WS_WRL);
    for (int i = gt; i < 48 * 1024; i += NGT) { const int c = i >> 10, k = i & 1023;
        const float w = c < 4 ? a.in[8][k * 4 + c] : (c < 36 ? a.in[10][k * 32 + (c - 4)] : 0.f);
        const unsigned hi = f2bf(w); const float rem = w - bf2f((unsigned short)hi);
        WH[i] = (bf16)hi; WL[i] = (bf16)f2bf(rem); }
}
__device__ __forceinline__ void moe_route_phase(Frame& F, const Args& a, const float* H) {
    LAS unsigned char* L = F.lds + RING_OFF;
    LAS float* LG = (LAS float*)(L + F.wave * 4096);
    LAS unsigned* lcnt = (LAS unsigned*)(L + 65536);
    const int lane = F.lane, l15 = lane & 15, fq = lane >> 4;
    const bf16* WH = (const bf16*)(a.ws + WS_WRH); const bf16* WL = (const bf16*)(a.ws + WS_WRL);
    int* EID = (int*)(a.ws + WS_EID); float* GATE = (float*)(a.ws + WS_GATE); int* CNT = (int*)(a.ws + WS_CNT);
    for (int vb = F.vcu; vb < 256; vb += F.G) {
        if (F.tid < 32) lcnt[F.tid] = 0u;
        __syncthreads();
        const int tile = vb * 8 + F.wave;
        f32x4 acc[3]; acc[0] = acc[1] = acc[2] = (f32x4){0.f, 0.f, 0.f, 0.f};
        const float* hrow = H + (size_t)(16 * tile + l15) * D + 8 * fq;
        for (int ks = 0; ks < 32; ++ks) {
            const f32x4 x0 = *(const f32x4*)(hrow + 32 * ks), x1 = *(const f32x4*)(hrow + 32 * ks + 4);
            float xs[8] = {x0[0], x0[1], x0[2], x0[3], x1[0], x1[1], x1[2], x1[3]};
            unsigned hw[4], lw[4];
#pragma unroll
            for (int p = 0; p < 4; ++p) { const unsigned h0 = f2bf(xs[2 * p]), h1 = f2bf(xs[2 * p + 1]);
                hw[p] = h0 | (h1 << 16); lw[p] = pk2(xs[2 * p] - bf2f((unsigned short)h0), xs[2 * p + 1] - bf2f((unsigned short)h1)); }
            const bf16x8 ah = __builtin_bit_cast(bf16x8, (v4u){hw[0], hw[1], hw[2], hw[3]}), al = __builtin_bit_cast(bf16x8, (v4u){lw[0], lw[1], lw[2], lw[3]});
#pragma unroll
            for (int nt = 0; nt < 3; ++nt) {
                const bf16x8 bh = *(const bf16x8*)(WH + (size_t)(16 * nt + l15) * 1024 + 32 * ks + 8 * fq), bl = *(const bf16x8*)(WL + (size_t)(16 * nt + l15) * 1024 + 32 * ks + 8 * fq);
                acc[nt] = __builtin_amdgcn_mfma_f32_16x16x32_bf16(ah, bh, acc[nt], 0, 0, 0);
                acc[nt] = __builtin_amdgcn_mfma_f32_16x16x32_bf16(ah, bl, acc[nt], 0, 0, 0);
                acc[nt] = __builtin_amdgcn_mfma_f32_16x16x32_bf16(al, bh, acc[nt], 0, 0, 0);
            }
        }
#pragma unroll
        for (int nt = 0; nt < 3; ++nt)
#pragma unroll
            for (int r = 0; r < 4; ++r) LG[(4 * fq + r) * 48 + 16 * nt + l15] = acc[nt][r];
        LDS_WAIT(); asm volatile("" ::: "memory");
        if (lane < 16) {
            const int tok = 16 * tile + lane; const LAS float* lg = LG + lane * 48;
            float gl[4]; int gs = 0; float gm = -INFINITY;
#pragma unroll
            for (int c = 0; c < 4; ++c) { gl[c] = lg[c] + a.in[9][c]; if (gl[c] > gm) { gm = gl[c]; gs = c; } }
            float den = 0.f;
#pragma unroll
            for (int c = 0; c < 4; ++c) den += __expf(gl[c] - gm);
            const float pg = 1.f / den;
            float t0v = -INFINITY, t1v = -INFINITY; int t0i = 0, t1i = 0;
            for (int c = 0; c < 8; ++c) { const float v = lg[4 + gs * 8 + c] + a.in[11][gs * 8 + c];
                if (v > t0v) { t1v = t0v; t1i = t0i; t0v = v; t0i = c; } else if (v > t1v) { t1v = v; t1i = c; } }
            const float p0 = 1.f / (1.f + __expf(t1v - t0v));
            const int e0 = gs * 8 + t0i, e1 = gs * 8 + t1i;
            EID[2 * tok] = e0; EID[2 * tok + 1] = e1; GATE[2 * tok] = p0 * pg; GATE[2 * tok + 1] = (1.f - p0) * pg;
            atomicAdd((unsigned*)&lcnt[e0], 1u); atomicAdd((unsigned*)&lcnt[e1], 1u);
        }
        __syncthreads();
        if (F.tid < 32) CNT[vb * 32 + F.tid] = (int)lcnt[F.tid];
        __syncthreads();
    }
}
__device__ __forceinline__ void moe_assign_phase(Frame& F, const Args& a) {
    LAS unsigned char* L = F.lds + RING_OFF;
    LAS int* tot = (LAS int*)(L); LAS int* bef = (LAS int*)(L + 128); LAS int* base = (LAS int*)(L + 256); LAS unsigned* lcnt = (LAS unsigned*)(L + 384); LAS int* posof = (LAS int*)(L + 1024);
    const int* EID = (const int*)(a.ws + WS_EID); const float* GATE = (const float*)(a.ws + WS_GATE); const int* CNT = (const int*)(a.ws + WS_CNT);
    int* OFFS = (int*)(a.ws + WS_OFFS); int* DEST = (int*)(a.ws + WS_DEST); float* GPOS = (float*)(a.ws + WS_GPOS);
    const bf16* HB = (const bf16*)(a.ws + WS_HB); bf16* XS = (bf16*)(a.ws + WS_XS);
    for (int vb = F.vcu; vb < 256; vb += F.G) {
        if (F.tid < 32) { int t = 0, b = 0; for (int k = 0; k < 256; ++k) { const int c = CNT[k * 32 + F.tid]; t += c; if (k < vb) b += c; } tot[F.tid] = t; bef[F.tid] = b; lcnt[F.tid] = 0u; }
        __syncthreads();
        if (F.tid < 32) { int off = 0; for (int e = 0; e < F.tid; ++e) off += (tot[e] + 255) & ~255; base[F.tid] = off + bef[F.tid];
            if (vb == 0) { OFFS[F.tid] = off; if (F.tid == 31) OFFS[32] = off + ((tot[31] + 255) & ~255); }
            if (vb == F.tid) { const int pend = off + ((tot[F.tid] + 255) & ~255); for (int p = off + tot[F.tid]; p < pend; ++p) DEST[p] = -1; } }
        __syncthreads();
        if (F.tid < 256) { const int item = vb * 256 + F.tid; const int e = EID[item];
            const int rank = (int)atomicAdd((unsigned*)&lcnt[e], 1u); const int pos = base[e] + rank;
            DEST[pos] = item; GPOS[pos] = GATE[item]; posof[F.tid] = pos; }
        __syncthreads();
        for (int it = F.wave; it < 256; it += NWAVES) { const int tok = vb * 128 + (it >> 1); const int pos = posof[it];
            const v4u* src = (const v4u*)(HB + (size_t)tok * D) + F.lane; v4u* dst = (v4u*)(XS + (size_t)pos * D) + F.lane;
            dst[0] = src[0]; dst[64] = src[64]; }
        __syncthreads();
    }
}
struct MoeOrder {
    int nun, G, c; LAS const unsigned char* tileE;
    __device__ __forceinline__ bool next(int i, pg8::Unit& u) const { const int Lx = i * G + c; if (Lx >= nun) return false; const int mt = Lx >> 2; u.pm = mt; u.pn = (int)tileE[mt] * 4 + (Lx & 3); return true; }
    __device__ __forceinline__ void a_ready(const pg8::Unit&) const {}
    __device__ __forceinline__ void done(const pg8::Unit&) const {}
};
__device__ __forceinline__ int moe_tile_table(Frame& F, const Args& a) {
    const int* OFFS = (const int*)(a.ws + WS_OFFS);
    LAS unsigned char* tileE = F.lds + TILEE_OFF;
    const int ntm = OFFS[32] >> 8;
    if (F.tid < MOE_MAXTILES) { int e = 0; for (int k = 1; k < 32; ++k) if (OFFS[k] <= F.tid * 256) e = k; tileE[F.tid] = (unsigned char)e; }
    __syncthreads();
    return ntm;
}
struct EpiGateUp {
    static constexpr bool PERM = true, AFTER_DRAIN = false;
    bf16* HM;
    __device__ __forceinline__ void operator()(const f32x4 (&acc)[2][2][4][2], const pg8::Unit& u, int wr, int wc, int fr, int fq) const {
        const int row0 = u.pm * 256 + wr * 64 + fr, pnl = u.pn & 3;
#pragma unroll
        for (int ai = 0; ai < 2; ++ai)
#pragma unroll
            for (int m = 0; m < 4; ++m) { const int r = row0 + ai * 128 + m * 16;
#pragma unroll
                for (int bj = 0; bj < 2; ++bj) { const int c0 = pnl * 256 + bj * 128 + wc * 32 + 8 * fq; const f32x4 gt = acc[ai][bj][m][0], up = acc[ai][bj][m][1];
                    v2u w; w.x = pk2(silu_f(gt[0]) * up[0], silu_f(gt[1]) * up[1]); w.y = pk2(silu_f(gt[2]) * up[2], silu_f(gt[3]) * up[3]);
                    *(v2u*)(HM + (size_t)r * 512 + (c0 >> 1)) = w; } }
    }
};
struct EpiScatter {
    static constexpr bool PERM = true, AFTER_DRAIN = false;
    bf16* FF; const int* DEST; const float* GPOS;
    __device__ __forceinline__ void operator()(const f32x4 (&acc)[2][2][4][2], const pg8::Unit& u, int wr, int wc, int fr, int fq) const {
        const int row0 = u.pm * 256 + wr * 64 + fr, pnl = u.pn & 3;
#pragma unroll
        for (int ai = 0; ai < 2; ++ai)
#pragma unroll
            for (int m = 0; m < 4; ++m) { const int r = row0 + ai * 128 + m * 16; const int dest = DEST[r]; const float gt = GPOS[r];
                if (dest >= 0) {
#pragma unroll
                    for (int bj = 0; bj < 2; ++bj) { const int c0 = pnl * 256 + bj * 128 + wc * 32 + 8 * fq; const f32x4 v0 = acc[ai][bj][m][0] * gt, v1 = acc[ai][bj][m][1] * gt;
                        v4u w; w.x = pk2(v0[0], v0[1]); w.y = pk2(v0[2], v0[3]); w.z = pk2(v1[0], v1[1]); w.w = pk2(v1[2], v1[3]);
                        *(v4u*)(FF + (size_t)dest * 1024 + c0) = w; } } }
    }
};
typedef _Float16 f16x8 __attribute__((ext_vector_type(8)));
constexpr int SEL_CAP = 128;
constexpr int SEL_THR = MISC_OFF + 1024, SEL_RREM = SEL_THR + 256, SEL_CCNT = SEL_RREM + 256;
constexpr int SEL_MASKIMG = 0, SEL_CAND = 65536;
__device__ __forceinline__ float sel_score(const f16x8 a, const f16x8 bA, const f16x8 bB, const f32x4 w) {
    const f32x4 z = {0.f, 0.f, 0.f, 0.f};
    const f32x4 dA = __builtin_amdgcn_mfma_f32_16x16x32_f16(a, bA, z, 0, 0, 0);
    const f32x4 dB = __builtin_amdgcn_mfma_f32_16x16x32_f16(a, bB, z, 0, 0, 0);
    float pA = w[0] * fmaxf(dA[0], 0.f); pA = __builtin_fmaf(w[1], fmaxf(dA[1], 0.f), pA); pA = __builtin_fmaf(w[2], fmaxf(dA[2], 0.f), pA); pA = __builtin_fmaf(w[3], fmaxf(dA[3], 0.f), pA);
    float pB = w[0] * fmaxf(dB[0], 0.f); pB = __builtin_fmaf(w[1], fmaxf(dB[1], 0.f), pB); pB = __builtin_fmaf(w[2], fmaxf(dB[2], 0.f), pB); pB = __builtin_fmaf(w[3], fmaxf(dB[3], 0.f), pB);
    asm volatile("s_nop 1\n\tv_permlane16_swap_b32 %0, %1" : "+v"(pA), "+v"(pB));
    return pA + pB;
}
__device__ __forceinline__ int sel_bin(float s) { const float c = __builtin_fminf(__builtin_fmaxf(s, -0.125f), 0.125f);
    return (int)__builtin_fminf(__builtin_fmaxf(__builtin_fmaf(s, 64.f, __builtin_fmaf(c, 448.f, 512.f)), 0.f), 1023.f); }
__device__ __forceinline__ void sel_unit(Frame& F, const Args& a, int b, int c) {
    LAS unsigned char* L = F.lds + RING_OFF;
    LAS int* THR = (LAS int*)(F.lds + SEL_THR); LAS int* RREM = (LAS int*)(F.lds + SEL_RREM); LAS int* CCNT = (LAS int*)(F.lds + SEL_CCNT);
    const int tid = F.tid, lane = F.lane, w = F.wave, l15 = lane & 15, fq = lane >> 4, half = lane >> 5;
    const unsigned short* IQ = (const unsigned short*)(a.ws + WS_IQ); const unsigned short* IK = (const unsigned short*)(a.ws + WS_IK); const float* IW = (const float*)(a.ws + WS_IW);
    const size_t qrow0 = (size_t)b * T + 64 * c + 8 * w, krow0 = (size_t)b * T;
    f16x8 af[4]; f32x4 wq[4];
#pragma unroll
    for (int rb = 0; rb < 4; ++rb) {
        af[rb] = *(const f16x8*)(IQ + (qrow0 + 2 * rb + (l15 >> 3)) * 256 + (l15 & 7) * 32 + 8 * fq);
        wq[rb] = *(const f32x4*)(IW + (qrow0 + 2 * rb + (fq >> 1)) * 8 + 4 * (fq & 1));
    }
    const unsigned short* ikl = IK + (krow0 + l15) * 32 + 8 * fq;
    if (c >= 4) {
        for (int i = tid; i < RING_BYTES / 16; i += NWAVES * 64) *(LAS v4u*)(L + i * 16) = (v4u){0u, 0u, 0u, 0u};
        __syncthreads();
        f16x8 bf[4];
#pragma unroll
        for (int kg = 0; kg < 4; ++kg) bf[kg] = *(const f16x8*)(ikl + (size_t)(16 * kg) * 32);
        for (int t = 0; t <= c; ++t) {
            f16x8 bn[4];
            const int tn = t < c ? t + 1 : t;
#pragma unroll
            for (int kg = 0; kg < 4; ++kg) bn[kg] = *(const f16x8*)(ikl + (size_t)(64 * tn + 16 * kg) * 32);
#pragma unroll
            for (int rb = 0; rb < 4; ++rb)
#pragma unroll
                for (int pp = 0; pp < 2; ++pp) {
                    const float s = sel_score(af[rb], bf[2 * pp], bf[2 * pp + 1], wq[rb]);
                    const int bin = sel_bin(s);
                    __hip_atomic_fetch_add((LAS unsigned*)(L + (8 * w + 2 * rb + half) * 2048 + (bin >> 1) * 4), (bin & 1) ? 65536u : 1u, __ATOMIC_RELAXED, __HIP_MEMORY_SCOPE_WORKGROUP);
                }
#pragma unroll
            for (int kg = 0; kg < 4; ++kg) bf[kg] = bn[kg];
        }
        __syncthreads();
        for (int qq = 0; qq < 8; ++qq) {
            const int q = 8 * w + qq;
            const v4u h0 = *(LAS const v4u*)(L + q * 2048 + lane * 32), h1 = *(LAS const v4u*)(L + q * 2048 + lane * 32 + 16);
            const unsigned hw[8] = {h0.x, h0.y, h0.z, h0.w, h1.x, h1.y, h1.z, h1.w};
            int tot = 0;
#pragma unroll
            for (int k = 0; k < 8; ++k) tot += (int)(hw[k] & 0xffffu) + (int)(hw[k] >> 16);
            int inc = tot;
#pragma unroll
            for (int o = 1; o < 64; o <<= 1) { const int v = __shfl_up(inc, o); if (lane >= o) inc += v; }
            const int all = __shfl(inc, 63);
            const int above = all - inc;
            if (above < 256 && above + tot >= 256) {
                int cum = above, B = 16 * lane, r = 1; bool done = false;
#pragma unroll
                for (int k = 7; k >= 0; --k) {
                    const int chi = (int)(hw[k] >> 16), clo = (int)(hw[k] & 0xffffu);
                    if (!done) { if (cum + chi >= 256) { B = 16 * lane + 2 * k + 1; r = 256 - cum; done = true; } else cum += chi; }
                    if (!done) { if (cum + clo >= 256) { B = 16 * lane + 2 * k; r = 256 - cum; done = true; } else cum += clo; }
                }
                THR[q] = B; RREM[q] = r;
            }
        }
    } else {
        if (tid < 64) { THR[tid] = -1; RREM[tid] = 0; }
    }
    __syncthreads();
    for (int i = tid; i < RING_BYTES / 16; i += NWAVES * 64) *(LAS v4u*)(L + i * 16) = (v4u){0u, 0u, 0u, 0u};
    if (tid < 64) CCNT[tid] = 0;
    __syncthreads();
    {
        int tb[4];
#pragma unroll
        for (int rb = 0; rb < 4; ++rb) tb[rb] = THR[8 * w + 2 * rb + half];
        f16x8 bf[4];
#pragma unroll
        for (int kg = 0; kg < 4; ++kg) bf[kg] = *(const f16x8*)(ikl + (size_t)(16 * kg) * 32);
        for (int t = 0; t <= c; ++t) {
            f16x8 bn[4];
            const int tn = t < c ? t + 1 : t;
#pragma unroll
            for (int kg = 0; kg < 4; ++kg) bn[kg] = *(const f16x8*)(ikl + (size_t)(64 * tn + 16 * kg) * 32);
#pragma unroll
            for (int rb = 0; rb < 4; ++rb)
#pragma unroll
                for (int pp = 0; pp < 2; ++pp) {
                    const float s = sel_score(af[rb], bf[2 * pp], bf[2 * pp + 1], wq[rb]);
                    const int bin = sel_bin(s);
                    const unsigned long long sm = __ballot(bin > tb[rb]);
                    if (lane == 0) { *(LAS unsigned*)(L + SEL_MASKIMG + (8 * w + 2 * rb) * 1024 + t * 8 + pp * 4) = (unsigned)sm;
                                     *(LAS unsigned*)(L + SEL_MASKIMG + (8 * w + 2 * rb + 1) * 1024 + t * 8 + pp * 4) = (unsigned)(sm >> 32); }
                    const bool cand = (bin == tb[rb]);
                    const unsigned long long cm = __ballot(cand);
                    if (cm) {
                        const unsigned mylo = (unsigned)(cm >> (32 * half));
                        const int q = 8 * w + 2 * rb + half;
                        const int cnt0 = CCNT[q];
                        const int slot = cnt0 + __popc(mylo & ((1u << (lane & 31)) - 1u));
                        if (cand && slot < SEL_CAP) *(LAS v2u*)(L + SEL_CAND + (q * SEL_CAP + slot) * 8) = (v2u){__builtin_bit_cast(unsigned, s), (unsigned)(64 * t + 32 * pp + (lane & 31))};
                        if ((lane & 31) == 0) CCNT[q] = cnt0 + __popc(mylo);
                    }
                }
#pragma unroll
            for (int kg = 0; kg < 4; ++kg) bf[kg] = bn[kg];
        }
    }
    LDS_WAIT(); asm volatile("" ::: "memory");
    for (int qq = 0; qq < 8; ++qq) {
        const int q = 8 * w + qq; const int n = min(CCNT[q], SEL_CAP), r = RREM[q];
        if (r > 0 && n > 0) {
            const v2u c0 = *(LAS const v2u*)(L + SEL_CAND + (q * SEL_CAP + lane) * 8), c1 = *(LAS const v2u*)(L + SEL_CAND + (q * SEL_CAP + 64 + lane) * 8);
            const float s0 = __builtin_bit_cast(float, c0.x), s1 = __builtin_bit_cast(float, c1.x);
            int rank0 = 0, rank1 = 0;
            for (int j = 0; j < n; ++j) { const v2u cj = *(LAS const v2u*)(L + SEL_CAND + (q * SEL_CAP + j) * 8); const float sj = __builtin_bit_cast(float, cj.x);
                rank0 += (sj > s0 || (sj == s0 && cj.y < c0.y)) ? 1 : 0; rank1 += (sj > s1 || (sj == s1 && cj.y < c1.y)) ? 1 : 0; }
            if (lane < n && rank0 < r) __hip_atomic_fetch_or((LAS unsigned*)(L + SEL_MASKIMG + q * 1024 + (c0.y >> 5) * 4), 1u << (c0.y & 31), __ATOMIC_RELAXED, __HIP_MEMORY_SCOPE_WORKGROUP);
            if (lane + 64 < n && rank1 < r) __hip_atomic_fetch_or((LAS unsigned*)(L + SEL_MASKIMG + q * 1024 + (c1.y >> 5) * 4), 1u << (c1.y & 31), __ATOMIC_RELAXED, __HIP_MEMORY_SCOPE_WORKGROUP);
        }
    }
    __syncthreads();
    { unsigned long long* MK = (unsigned long long*)(a.ws + WS_MASK);
      const int ntw = (c | 3) + 1;
      for (int i = tid; i < ntw * 64; i += NWAVES * 64) { const int t = i >> 6, q = i & 63;
          MK[((size_t)b * NCHUNK + t) * T + 64 * c + q] = *(LAS const unsigned long long*)(L + SEL_MASKIMG + q * 1024 + t * 8); } }
    __syncthreads();
}
__device__ __forceinline__ void sel_phase(Frame& F, const Args& a) {
    for (int v = F.vcu; v < 256; v += F.G) { const int b = v >> 6, p = v & 63; sel_unit(F, a, b, p); sel_unit(F, a, b, 127 - p); }
}
namespace attn_body {
using bf16=__hip_bfloat16;
using bf16x8=__attribute__((ext_vector_type(8)))short;
using s16x4=__attribute__((ext_vector_type(4)))short;
using f32x16=__attribute__((ext_vector_type(16)))float;
using u32x4=__attribute__((ext_vector_type(4)))unsigned;
constexpr int BATCH=4,NHEAD=8,SEQ=8192,D=64,DM=NHEAD*D,OPITCH=1024;
constexpr int NW=8,QBLK=32,QB=QBLK*NW,KVBLK=64,NQB=SEQ/QB;
constexpr int ATTN_PITCH=DM, ATTN_UNIT_ROWS=QB;
__device__ __forceinline__ int crow(int r,int hi){return (r&3)+8*(r>>2)+4*hi;}
#define SBAR() __builtin_amdgcn_sched_barrier(0)
constexpr int NSLOT=3, SLOTB=8192;
constexpr int LDS_K=0, LDS_V=NSLOT*SLOTB, LDS_WS=2*NSLOT*SLOTB, LDS_OST=LDS_WS+NW*64*4, LDS_MSK=LDS_OST+NW*4096, LDS_BYTES=LDS_MSK+NSLOT*2048;
constexpr float C2=0.125f*1.4426950408889634f;
__device__ __forceinline__ void glds16(const void*gsrc,unsigned lds_dst){unsigned keep;
  asm volatile("s_mov_b32 %0, m0\n\ts_mov_b32 m0, %2\n\ts_nop 0\n\tglobal_load_lds_dwordx4 %1, off\n\ts_mov_b32 m0, %0":"=&s"(keep):"v"(gsrc),"s"(lds_dst):"memory");}
__device__ __forceinline__ void glds4(const void*gsrc,unsigned lds_dst){unsigned keep;
  asm volatile("s_mov_b32 %0, m0\n\ts_mov_b32 m0, %2\n\ts_nop 0\n\tglobal_load_lds_dword %1, off\n\ts_mov_b32 m0, %0":"=&s"(keep):"v"(gsrc),"s"(lds_dst):"memory");}
__device__ __forceinline__ float max3f(float a,float b,float c){float r;asm("v_max3_f32 %0, %1, %2, %3":"=v"(r):"v"(a),"v"(b),"v"(c));return r;}
__device__ __forceinline__ float max2f(float a,float b){float r;asm("v_max_f32_e32 %0, %1, %2":"=v"(r):"v"(a),"v"(b));return r;}
__device__ __forceinline__ float fadd_s(float a,float b){float r;asm("v_add_f32_e32 %0, %1, %2":"=v"(r):"v"(a),"v"(b));return r;}
__device__ __forceinline__ float fsub_s(float a,float b){float r;asm("v_sub_f32_e32 %0, %1, %2":"=v"(r):"v"(a),"v"(b));return r;}
typedef float f32x2_t __attribute__((ext_vector_type(2))); typedef __bf16 bf16x2_t __attribute__((ext_vector_type(2)));
__device__ __forceinline__ unsigned cvtpk_s(float lo,float hi){f32x2_t v={lo,hi};bf16x2_t b=__builtin_convertvector(v,bf16x2_t);return __builtin_bit_cast(unsigned,b);}
#define WAIT_BAR(N) asm volatile("s_waitcnt vmcnt(" #N ") lgkmcnt(0)\n\ts_barrier":::"memory")

__device__ __forceinline__ void qkt(f32x16&p0,f32x16&p1,const char*Kslot,const bf16x8*qr,const f32x16&negm,int r32,int hi){
  const char*kb=Kslot+hi*1024+r32*16;
  #pragma unroll
  for(int d0=0;d0<4;++d0){
    const bf16x8 b0=*reinterpret_cast<const bf16x8*>(kb+d0*2048);
    const bf16x8 b1=*reinterpret_cast<const bf16x8*>(kb+d0*2048+512);
    if(d0==0){p0=__builtin_amdgcn_mfma_f32_32x32x16_bf16(b0,qr[0],negm,0,0,0);p1=__builtin_amdgcn_mfma_f32_32x32x16_bf16(b1,qr[0],negm,0,0,0);}
    else{p0=__builtin_amdgcn_mfma_f32_32x32x16_bf16(b0,qr[d0],p0,0,0,0);p1=__builtin_amdgcn_mfma_f32_32x32x16_bf16(b1,qr[d0],p1,0,0,0);}}
}
typedef __attribute__((address_space(3))) const char* lds_cptr;
typedef short v4i16_t __attribute__((ext_vector_type(4)));
__device__ __forceinline__ void kload8(bf16x8*kf,lds_cptr kp){
  kf[0]=*(const __attribute__((address_space(3))) bf16x8*)(kp);      kf[1]=*(const __attribute__((address_space(3))) bf16x8*)(kp+512);
  kf[2]=*(const __attribute__((address_space(3))) bf16x8*)(kp+2048); kf[3]=*(const __attribute__((address_space(3))) bf16x8*)(kp+2560);
  kf[4]=*(const __attribute__((address_space(3))) bf16x8*)(kp+4096); kf[5]=*(const __attribute__((address_space(3))) bf16x8*)(kp+4608);
  kf[6]=*(const __attribute__((address_space(3))) bf16x8*)(kp+6144); kf[7]=*(const __attribute__((address_space(3))) bf16x8*)(kp+6656);
}
__device__ __forceinline__ void kload2(bf16x8*kf,lds_cptr kp,int j){ kf[2*j]=*(const __attribute__((address_space(3))) bf16x8*)(kp+j*2048); kf[2*j+1]=*(const __attribute__((address_space(3))) bf16x8*)(kp+j*2048+512); }
__device__ __forceinline__ s16x4 vtr(lds_cptr p){ return __builtin_bit_cast(s16x4,__builtin_amdgcn_ds_read_tr16_b64_v4i16((__attribute__((address_space(3))) v4i16_t*)p)); }
__device__ __forceinline__ float rowmax(const f32x16&p0,const f32x16&p1){
  float a=max3f(p0[0],p0[1],p1[0]),b=max3f(p0[2],p0[3],p1[1]);a=max3f(a,p1[2],p1[3]);
  #pragma unroll
  for(int r=4;r<16;r+=4){a=max3f(a,p0[r],p0[r+1]);b=max3f(b,p0[r+2],p0[r+3]);a=max3f(a,p1[r],p1[r+1]);b=max3f(b,p1[r+2],p1[r+3]);}
  const float m=max2f(a,b);
  auto rr=__builtin_amdgcn_permlane32_swap(__float_as_uint(m),__float_as_uint(m),false,false);
  return max2f(__uint_as_float(rr[0]),__uint_as_float(rr[1]));
}
__device__ __forceinline__ void pv(f32x16*o,int vb,bf16x8 pa0,bf16x8 pa1,bf16x8 pa2,bf16x8 pa3){
  #pragma unroll
  for(int d0=0;d0<2;++d0){s16x4 lo[4],hi[4];
    #pragma unroll
    for(int ks=0;ks<4;++ks){
      asm volatile("ds_read_b64_tr_b16 %0,%1 offset:%c2":"=&v"(lo[ks]):"v"(vb),"i"(d0*4096+ks*1024):"memory");
      asm volatile("ds_read_b64_tr_b16 %0,%1 offset:%c2":"=&v"(hi[ks]):"v"(vb),"i"(d0*4096+ks*1024+512):"memory");}
    asm volatile("s_waitcnt lgkmcnt(0)":::"memory");SBAR();
    #define PK(k) (bf16x8){lo[k][0],lo[k][1],lo[k][2],lo[k][3],hi[k][0],hi[k][1],hi[k][2],hi[k][3]}
    o[d0]=__builtin_amdgcn_mfma_f32_32x32x16_bf16(pa0,PK(0),o[d0],0,0,0);
    o[d0]=__builtin_amdgcn_mfma_f32_32x32x16_bf16(pa1,PK(1),o[d0],0,0,0);
    o[d0]=__builtin_amdgcn_mfma_f32_32x32x16_bf16(pa2,PK(2),o[d0],0,0,0);
    o[d0]=__builtin_amdgcn_mfma_f32_32x32x16_bf16(pa3,PK(3),o[d0],0,0,0);
    #undef PK
  }
}

#ifndef ATTN_STORE16
#define ATTN_STORE16(p,v) (*(u32x4*)(p)=(v))
#endif
template<int THRL> __device__ __forceinline__ void attn_unit(int b,int h,int qb,const bf16*Q,const bf16*__restrict__ K,const bf16*__restrict__ V,bf16*O,const unsigned*MSK,char*shm){
  const int tid=threadIdx.x,lane=tid&63,r32=lane&31,hi=lane>>5; const int wid=__builtin_amdgcn_readfirstlane(tid>>6);
  const long rowbase=(long)b*SEQ; const int q0=qb*QB;
  const bf16*Qw=Q+(rowbase+q0+wid*QBLK)*DM+h*D;
  const bf16*Kh=K+rowbase*DM+h*D,*Vh=V+rowbase*DM+h*D;
  const unsigned lds0=(unsigned)(uintptr_t)shm;
  float*wsf=(float*)(shm+LDS_WS)+wid*64;
  const bf16*ksrc=Kh+(long)lane*DM+wid*8;
  const bf16*vsrc=Vh+(long)(16*(wid&3)+(lane>>2))*DM+(wid>>2)*32+(lane&3)*8;
  const unsigned kdst=lds0+LDS_K+wid*1024, vdst=lds0+LDS_V+wid*1024, mdst=lds0+LDS_MSK+wid*256;
  const unsigned*msrc=MSK+(((size_t)b*(SEQ/KVBLK))*SEQ+q0+wid*QBLK)*2+lane;
  typedef __attribute__((address_space(3))) const unsigned long long* lds_u64p;
  #define DMA_K(t,slot) glds16(ksrc+(long)(t)*KVBLK*DM,(unsigned)__builtin_amdgcn_readfirstlane(kdst+(slot)))
  #define DMA_V(t,slot) do{ glds16(vsrc+(long)(t)*KVBLK*DM,(unsigned)__builtin_amdgcn_readfirstlane(vdst+(slot))); glds4(msrc+(size_t)(t)*SEQ*2,(unsigned)__builtin_amdgcn_readfirstlane(mdst+((slot)>>2))); }while(0)
  const int vb0=(int)(lds0+LDS_V)+((lane>>4)&1)*32+(lane&3)*8+(4*hi+((lane&15)>>2))*64;
  const char*Kbase=shm+LDS_K; bf16x8 kf[8];
  const lds_cptr shm3=(lds_cptr)shm; const lds_cptr kp0=shm3+LDS_K+hi*1024+r32*16; const lds_cptr vp0=shm3+LDS_V+((lane>>4)&1)*32+(lane&3)*8+(4*hi+((lane&15)>>2))*64;
  const lds_cptr mp0=shm3+LDS_MSK+wid*256+r32*8;
  const int NT=(q0+QB)/KVBLK;
  DMA_K(0,0);DMA_V(0,0);DMA_K(1,SLOTB);
  bf16x8 qr[4];
  #pragma unroll
  for(int d0=0;d0<4;++d0)qr[d0]=*reinterpret_cast<const bf16x8*>(&Qw[(long)r32*DM+d0*16+hi*8]);
  float mhat=0.f,l_reg=0.f;f32x16 o[2];o[0]=f32x16{};o[1]=f32x16{};f32x16 negm=f32x16{};asm volatile("":"+v"(negm));
  const int qrel=wid*QBLK+r32;
  bool resc=false;
  #define START(P0,P1) do{ const float rm=rowmax(P0,P1); resc=false; \
    { const float dl=rm; mhat=fadd_s(mhat,dl); \
      _Pragma("unroll") for(int r=0;r<16;++r){P0[r]=fsub_s(P0[r],dl);P1[r]=fsub_s(P1[r],dl);} \
      _Pragma("unroll") for(int r=0;r<16;++r)negm[r]=-mhat; asm volatile("":"+v"(negm)); } \
    _Pragma("unroll") for(int r=0;r<16;++r)P0[r]=__builtin_amdgcn_exp2f(P0[r]); }while(0)
  #define RESC() do{ if(resc){ asm volatile("s_waitcnt lgkmcnt(0)":::"memory"); \
      _Pragma("unroll") for(int d_=0;d_<2;++d_) _Pragma("unroll") for(int r=0;r<16;++r)o[d_][r]*=wsf[crow(r,hi)]; } }while(0)
  f32x16 pA0,pA1,pB0,pB1;
  int sl_prev=0,sl_cur=0,sl_next=SLOTB;
  #define ROT() do{sl_prev=sl_cur;sl_cur=sl_next;sl_next=(sl_next==(NSLOT-1)*SLOTB)?0:sl_next+SLOTB;}while(0)
  DMA_K(2,2*SLOTB);
  WAIT_BAR(4);
  qkt(pA0,pA1,Kbase,qr,negm,r32,hi);asm volatile("s_nop 15\n\ts_nop 7":"+v"(pA0),"+v"(pA1));
  START(pA0,pA1);
  _Pragma("unroll") for(int r=0;r<16;++r)pA1[r]=__builtin_amdgcn_exp2f(pA1[r]);
  WAIT_BAR(0);
  DMA_K(3,0);DMA_V(1,SLOTB);
  ROT();
  kload8(kf,kp0+sl_cur);
  WAIT_BAR(3);
  s16x4 vlo[8],vhi[8]; u32x4 pw0,pw1,pw2,pw3;
  #define PKW(P,B) cvtpk_s(P[B],P[B+1])
  #define PAF(k) __builtin_bit_cast(bf16x8,pw##k)
  #define VFR(i) (bf16x8){vlo[i][0],vlo[i][1],vlo[i][2],vlo[i][3],vhi[i][0],vhi[i][1],vhi[i][2],vhi[i][3]}
  #define PIN(x) asm volatile("":"+v"(x))
  #define MX3(a,b,c) __builtin_fmaxf(__builtin_fmaxf((a),(b)),(c))
  #define MKB(P,r,W) do{ const float pv_=P[r]; P[r]=__uint_as_float(__float_as_uint(pv_)&(unsigned)__builtin_amdgcn_sbfe((int)(W),((r)&3)+8*((r)>>2),1)); }while(0)
  #define GAPA(MF,M0,M1,M2,M3,A0,A1,A2,A3,W0,W1,PW) do{ MF; M0; M1; M2; M3; sacc+=A0; sacc+=A1; sacc+=A2; sacc+=A3; PIN(sacc); W0; W1; PIN(PW); SBAR(); }while(0)
  #define EX(v) __builtin_amdgcn_exp2f(v)
  #define GAPB(MF,X,B) do{ MF; X[B]=EX(X[B]); X[B+1]=EX(X[B+1]); X[B+2]=EX(X[B+2]); X[B+3]=EX(X[B+3]); PIN(X); SBAR(); }while(0)
  #define VRD(i) do{ vlo[i]=vtr(vp_+(((i)>>2)*4096+((i)&3)*1024)); vhi[i]=vtr(vp_+(((i)>>2)*4096+((i)&3)*1024+512)); }while(0)
  #define KRD(G,j) do{ if(G){ kload2(kf,kp0+sl_next,j); SBAR(); } }while(0)
  #define STEP(C0,C1,P0,P1,t,GK,GV,GL) do{ SBAR(); \
    const lds_cptr vp_=vp0+sl_prev; \
    const unsigned long long mw_=*(lds_u64p)(mp0+(sl_prev>>2)); const unsigned mlo_=(unsigned)mw_>>(4*hi), mhi_=(unsigned)(mw_>>32)>>(4*hi); \
    VRD(0); SBAR(); MKB(P0,0,mlo_); MKB(P0,1,mlo_); float sacc=(P0[0]+P0[1]); \
    GAPA(C0=__builtin_amdgcn_mfma_f32_32x32x16_bf16(kf[0],qr[0],negm,0,0,0), MKB(P0,2,mlo_),MKB(P0,3,mlo_),MKB(P0,4,mlo_),MKB(P0,5,mlo_), P0[2],P0[3],P0[4],P0[5],     pw0[0]=PKW(P0,0), pw0[1]=PKW(P0,2), pw0); \
    VRD(4); SBAR(); GAPA(C1=__builtin_amdgcn_mfma_f32_32x32x16_bf16(kf[1],qr[0],negm,0,0,0), MKB(P0,6,mlo_),MKB(P0,7,mlo_),MKB(P0,8,mlo_),MKB(P0,9,mlo_), P0[6],P0[7],P0[8],P0[9],     pw0[2]=PKW(P0,4), pw0[3]=PKW(P0,6), pw0); \
    VRD(1); SBAR(); GAPA(C0=__builtin_amdgcn_mfma_f32_32x32x16_bf16(kf[2],qr[1],C0,0,0,0),   MKB(P0,10,mlo_),MKB(P0,11,mlo_),MKB(P0,12,mlo_),MKB(P0,13,mlo_), P0[10],P0[11],P0[12],P0[13], pw1[0]=PKW(P0,8), pw1[1]=PKW(P0,10), pw1); \
    VRD(5); SBAR(); GAPA(C1=__builtin_amdgcn_mfma_f32_32x32x16_bf16(kf[3],qr[1],C1,0,0,0),   MKB(P0,14,mlo_),MKB(P0,15,mlo_),MKB(P1,0,mhi_),MKB(P1,1,mhi_), P0[14],P0[15],P1[0],P1[1],   pw1[2]=PKW(P0,12),pw1[3]=PKW(P0,14), pw1); \
    VRD(2); SBAR(); GAPA(C0=__builtin_amdgcn_mfma_f32_32x32x16_bf16(kf[4],qr[2],C0,0,0,0),   MKB(P1,2,mhi_),MKB(P1,3,mhi_),MKB(P1,4,mhi_),MKB(P1,5,mhi_), P1[2],P1[3],P1[4],P1[5],     pw2[0]=PKW(P1,0), pw2[1]=PKW(P1,2), pw2); \
    VRD(6); SBAR(); GAPA(C1=__builtin_amdgcn_mfma_f32_32x32x16_bf16(kf[5],qr[2],C1,0,0,0),   MKB(P1,6,mhi_),MKB(P1,7,mhi_),MKB(P1,8,mhi_),MKB(P1,9,mhi_), P1[6],P1[7],P1[8],P1[9],     pw2[2]=PKW(P1,4), pw2[3]=PKW(P1,6), pw2); \
    VRD(3); SBAR(); GAPA(C0=__builtin_amdgcn_mfma_f32_32x32x16_bf16(kf[6],qr[3],C0,0,0,0),   MKB(P1,10,mhi_),MKB(P1,11,mhi_),MKB(P1,12,mhi_),MKB(P1,13,mhi_), P1[10],P1[11],P1[12],P1[13], pw3[0]=PKW(P1,8), pw3[1]=PKW(P1,10), pw3); \
    VRD(7); SBAR(); GAPA(C1=__builtin_amdgcn_mfma_f32_32x32x16_bf16(kf[7],qr[3],C1,0,0,0),   MKB(P1,14,mhi_),MKB(P1,15,mhi_),do{}while(0),do{}while(0), P1[14],P1[15],0.f,0.f,       pw3[2]=PKW(P1,12),pw3[3]=PKW(P1,14), pw3); \
    l_reg+=sacc; \
    if(GK){DMA_K((t)+3,sl_cur);} if(GV){DMA_V((t)+1,sl_next);} \
    { float a=MX3(C0[0],C0[1],C1[0]),b=MX3(C0[2],C0[3],C1[1]); a=MX3(a,C1[2],C1[3]); \
      _Pragma("unroll") for(int r=4;r<16;r+=4){a=MX3(a,C0[r],C0[r+1]);b=MX3(b,C0[r+2],C0[r+3]);a=MX3(a,C1[r],C1[r+1]);b=MX3(b,C1[r+2],C1[r+3]);} \
      float rm=__builtin_fmaxf(a,b); { auto rr=__builtin_amdgcn_permlane32_swap(__float_as_uint(rm),__float_as_uint(rm),false,false); rm=__builtin_fmaxf(__uint_as_float(rr[0]),__uint_as_float(rr[1])); } \
      resc=false; \
      if(__builtin_expect(__any(rm>(float)THRL),0)){ const float dl=__builtin_fmaxf(rm,0.f); mhat+=dl; \
        _Pragma("unroll") for(int r=0;r<16;++r){C0[r]-=dl;C1[r]-=dl;} \
        _Pragma("unroll") for(int r=0;r<16;++r)negm[r]=-mhat; asm volatile("":"+v"(negm)); \
        const float f=__builtin_amdgcn_exp2f(-dl); l_reg*=f; if(hi==0)wsf[r32]=f; resc=true; } } \
    SBAR(); \
    GAPB(o[0]=__builtin_amdgcn_mfma_f32_32x32x16_bf16(PAF(0),VFR(0),o[0],0,0,0), C0,0); \
    GAPB(o[1]=__builtin_amdgcn_mfma_f32_32x32x16_bf16(PAF(0),VFR(4),o[1],0,0,0), C0,4); \
    KRD(GL,0); GAPB(o[0]=__builtin_amdgcn_mfma_f32_32x32x16_bf16(PAF(1),VFR(1),o[0],0,0,0), C0,8); \
    KRD(GL,1); GAPB(o[1]=__builtin_amdgcn_mfma_f32_32x32x16_bf16(PAF(1),VFR(5),o[1],0,0,0), C0,12); \
    KRD(GL,2); GAPB(o[0]=__builtin_amdgcn_mfma_f32_32x32x16_bf16(PAF(2),VFR(2),o[0],0,0,0), C1,0); \
    KRD(GL,3); GAPB(o[1]=__builtin_amdgcn_mfma_f32_32x32x16_bf16(PAF(2),VFR(6),o[1],0,0,0), C1,4); \
    GAPB(o[0]=__builtin_amdgcn_mfma_f32_32x32x16_bf16(PAF(3),VFR(3),o[0],0,0,0), C1,8); \
    GAPB(o[1]=__builtin_amdgcn_mfma_f32_32x32x16_bf16(PAF(3),VFR(7),o[1],0,0,0), C1,12); \
    }while(0)
  int t=1;
  for(;t+5<NT;t+=2){
    STEP(pB0,pB1,pA0,pA1,t,true,true,true);     WAIT_BAR(3); RESC(); ROT();
    STEP(pA0,pA1,pB0,pB1,t+1,true,true,true);   WAIT_BAR(3); RESC(); ROT();
  }
  #define ENDW(tt) do{ if((tt)+3<NT){WAIT_BAR(3);} else if((tt)+2<NT){WAIT_BAR(2);} else {WAIT_BAR(0);} }while(0)
  for(;t+1<NT;t+=2){
    STEP(pB0,pB1,pA0,pA1,t,(t+3<NT),(t+1<NT),(t+1<NT));       ENDW(t);   RESC(); ROT();
    STEP(pA0,pA1,pB0,pB1,t+1,(t+4<NT),(t+2<NT),(t+2<NT));     ENDW(t+1); RESC(); ROT();
  }
  STEP(pB0,pB1,pA0,pA1,NT-1,false,false,false); RESC();
  { const unsigned long long mwd=*(lds_u64p)(mp0+(sl_cur>>2)); const unsigned mlo_=(unsigned)mwd>>(4*hi), mhi_=(unsigned)(mwd>>32)>>(4*hi);
    _Pragma("unroll") for(int r=0;r<16;++r){ MKB(pB0,r,mlo_); MKB(pB1,r,mhi_); }
    float sacc=pB0[0]+pB0[1]; _Pragma("unroll") for(int r=2;r<16;++r)sacc+=pB0[r]; _Pragma("unroll") for(int r=0;r<16;++r)sacc+=pB1[r]; l_reg+=sacc;
    pw0=(u32x4){PKW(pB0,0),PKW(pB0,2),PKW(pB0,4),PKW(pB0,6)};pw1=(u32x4){PKW(pB0,8),PKW(pB0,10),PKW(pB0,12),PKW(pB0,14)};pw2=(u32x4){PKW(pB1,0),PKW(pB1,2),PKW(pB1,4),PKW(pB1,6)};pw3=(u32x4){PKW(pB1,8),PKW(pB1,10),PKW(pB1,12),PKW(pB1,14)};
    SBAR(); pv(o,vb0+sl_cur,PAF(0),PAF(1),PAF(2),PAF(3)); }
  #undef PKW
  #undef PAF
  #undef VFR
  #undef PIN
  #undef MX3
  #undef GAPA
  #undef MKB
  #undef GAPB
  #undef EX
  #undef VRD
  #undef KRD
  #undef STEP
  #undef ENDW
  {auto rr=__builtin_amdgcn_permlane32_swap(__float_as_uint(l_reg),__float_as_uint(l_reg),false,false);l_reg=__uint_as_float(rr[0])+__uint_as_float(rr[1]);}
  if(hi==0)wsf[32+r32]=l_reg;asm volatile("s_waitcnt lgkmcnt(0)":::"memory");
  float rli[16];
  #pragma unroll
  for(int r=0;r<16;++r)rli[r]=__builtin_amdgcn_rcpf(wsf[32+crow(r,hi)]);
  bf16*Ow=O+(rowbase+q0+wid*QBLK)*OPITCH+h*D;
  { bf16*stg=(bf16*)(shm+LDS_OST)+wid*2048;
    #pragma unroll
    for(int r=0;r<16;++r){const int orow=crow(r,hi);
      #pragma unroll
      for(int d0=0;d0<2;++d0)stg[orow*64+d0*32+r32]=__float2bfloat16(o[d0][r]*rli[r]);}
    asm volatile("s_waitcnt lgkmcnt(0)":::"memory");
    #pragma unroll
    for(int i=0;i<4;++i){const int row=i*8+(lane>>3),ch=lane&7; const u32x4 v=*(const u32x4*)(stg+row*64+ch*8); ATTN_STORE16(Ow+(long)row*OPITCH+ch*8,v);} }
  asm volatile("s_waitcnt lgkmcnt(0)\n\ts_barrier":::"memory");
  #undef DMA_K
  #undef DMA_V
  #undef START
  #undef RESC
  #undef ROT
}
constexpr int ATTN_LDS_BYTES=LDS_BYTES;
struct AttnTensors { const bf16* Q; const bf16* K; const bf16* V; bf16* O; const unsigned* MSK; };
struct AttnUnit { int bh; int qb; };
struct StaticOrder {
  int vcu;
  __device__ __forceinline__ explicit StaticOrder(int grid,int block):vcu((block%8)*(grid/8)+block/8){}
  __device__ __forceinline__ bool next(int i,AttnUnit&u)const{ if(i>=4)return false; const int s=vcu&7; u.bh=vcu>>3; u.qb=(i==0)?s:(i==1)?15-s:(i==2)?16+s:31-s; return true; }
  __device__ __forceinline__ void a_ready(const AttnUnit&)const{}
  __device__ __forceinline__ void done(const AttnUnit&)const{}
};
template<class Sched,int THRL=8> __device__ __forceinline__ void attn_phase(char*lds,const AttnTensors&T,const Sched&S){
  AttnUnit u;
  for(int i=0;S.next(i,u);++i){ S.a_ready(u); attn_unit<THRL>(u.bh/NHEAD,u.bh%NHEAD,u.qb,T.Q,T.K,T.V,T.O,T.MSK,lds); S.done(u); }
}
#undef SBAR
#undef WAIT_BAR
}
constexpr int N_PHASES = 12;
__global__ void __launch_bounds__(NWAVES * 64, 2) mk_fwd(Args args) {
    extern __shared__ __attribute__((aligned(16))) unsigned char lds[];
    Frame F;
    F.lds = (LAS unsigned char*)lds;
    F.MISC = (volatile LAS unsigned*)(F.lds + MISC_OFF);
    F.tid = threadIdx.x; F.lane = F.tid & 63; F.wave = __builtin_amdgcn_readfirstlane(F.tid >> 6);
    F.G = gridDim.x; { const int bx = blockIdx.x; F.vcu = (F.G % 8 == 0) ? (bx % 8) * (F.G / 8) + bx / 8 : bx; }
    unsigned char* ws = args.ws;
    F.ctl = (gu32*)(ws + WS_CTL);
    for (int u = F.tid; u < (LDS_BYTES - LDSCTL_OFF) / 4; u += NWAVES * 64) ((LAS unsigned*)(F.lds + LDSCTL_OFF))[u] = 0u;
    __syncthreads();
    XcdBarrier bar = xcd_barrier_post((unsigned*)(F.ctl + CW_BAR), F.MISC + 8);
    const int lo = args.ph_lo, hi = args.ph_hi;
#define IN(k) (lo <= (k) && (k) < hi)
#define BOTH(k) (IN(k) && IN((k) + 1))
#define GRID_BAR() xcd_barrier(bar)
    float* KVT = (float*)((unsigned char*)args.out + OUT_KVT); bf16* SPREV = (bf16*)((unsigned char*)args.out + OUT_SPREV); float* DEC = (float*)(ws + WS_DEC);
    if (IN(0)) { p0_prologue(F, args); p0_router_weights(F, args); if (BOTH(0)) GRID_BAR(); }
    if (IN(1)) {
        pg8::Gemm g{(const pg8::bf16_t*)(ws + WS_XB), (const pg8::bf16_t*)(ws + WS_WIN), M, NPROJ, D}; pg8::StaticOrder S; S.init(M, NPROJ, F.G, (int)blockIdx.x);
        EpiProj E{ws};
        pg8::gemm_phase<EpiProj, pg8::StaticOrder, true, true>(F.lds + RING_OFF, g, S, E);
        if (BOTH(1)) GRID_BAR();
    }
    if (IN(2)) { sel_phase(F, args); gla_phase_a(F, args, KVT, DEC); if (BOTH(2)) GRID_BAR(); }
    if (IN(3)) { gla_phase_b(F, KVT, DEC, SPREV); if (BOTH(3)) GRID_BAR(); }
    if (IN(4)) {
        gla_phase_c(F, args, SPREV);
        static_assert(attn_body::ATTN_LDS_BYTES <= RING_BYTES, "attention LDS");
        const attn_body::AttnTensors AT{(const attn_body::bf16*)(ws + WS_AQ), (const attn_body::bf16*)(ws + WS_AK), (const attn_body::bf16*)(ws + WS_AV), (attn_body::bf16*)(ws + WS_Y), (const unsigned*)(ws + WS_MASK)};
        const attn_body::StaticOrder S((int)F.G, (int)blockIdx.x);
        attn_body::attn_phase<attn_body::StaticOrder>((char*)lds + RING_OFF, AT, S);
        if (BOTH(4)) GRID_BAR();
    }
    if (IN(5)) {
        pg8::Gemm g{(const pg8::bf16_t*)(ws + WS_Y), (const pg8::bf16_t*)(ws + WS_WO), M, D, D}; pg8::StaticOrder S; S.init(M, D, F.G, (int)blockIdx.x);
        EpiF32 E{args.out, D};
        pg8::gemm_phase<EpiF32, pg8::StaticOrder, true, true>(F.lds + RING_OFF, g, S, E);
        if (BOTH(5)) GRID_BAR();
    }
    if (IN(6)) { ln1_phase(F, args, args.out, (bf16*)(ws + WS_HB)); if (BOTH(6)) GRID_BAR(); }
    if (IN(7)) { moe_route_phase(F, args, args.out); if (BOTH(7)) GRID_BAR(); }
    if (IN(8)) { moe_assign_phase(F, args); if (BOTH(8)) GRID_BAR(); }
    if (IN(9)) {
        const int ntm = moe_tile_table(F, args);
        pg8::Gemm g{(const pg8::bf16_t*)(ws + WS_XS), (const pg8::bf16_t*)(ws + WS_WEI), 0, 0, 1024};
        MoeOrder S{ntm * 4, F.G, (int)blockIdx.x, F.lds + TILEE_OFF};
        EpiGateUp E{(bf16*)(ws + WS_HMID)};
        pg8::gemm_phase<EpiGateUp, MoeOrder, true, true>(F.lds + RING_OFF, g, S, E);
        if (BOTH(9)) GRID_BAR();
    }
    if (IN(10)) {
        const int ntm = moe_tile_table(F, args);
        pg8::Gemm g{(const pg8::bf16_t*)(ws + WS_HMID), (const pg8::bf16_t*)(ws + WS_WEO), 0, 0, 512};
        MoeOrder S{ntm * 4, F.G, (int)blockIdx.x, F.lds + TILEE_OFF};
        EpiScatter E{(bf16*)(ws + WS_FFN2), (const int*)(ws + WS_DEST), (const float*)(ws + WS_GPOS)};
        pg8::gemm_phase<EpiScatter, MoeOrder, true, true>(F.lds + RING_OFF, g, S, E);
        if (BOTH(10)) GRID_BAR();
    }
    if (IN(11)) { ln2_phase(F, args, args.out, (const bf16*)(ws + WS_FFN2)); }
#undef IN
#undef BOTH
}

extern "C" void kernel_launch(void* const* d_in, const int* in_sizes, int n_in, void* d_out, int out_size, void* d_ws, size_t ws_size, hipStream_t stream) {
    static int grid = 0;
    if (grid == 0) {
        int dev = 0, cus = 0, per_cu = 0;
        if (hipGetDevice(&dev) != hipSuccess || hipDeviceGetAttribute(&cus, hipDeviceAttributeMultiprocessorCount, dev) != hipSuccess) { grid = -1; return; }
        if (hipFuncSetAttribute((const void*)mk_fwd, hipFuncAttributeMaxDynamicSharedMemorySize, LDS_BYTES) != hipSuccess) { grid = -1; return; }
        if (hipOccupancyMaxActiveBlocksPerMultiprocessor(&per_cu, (const void*)mk_fwd, NWAVES * 64, LDS_BYTES) != hipSuccess || per_cu < 1) { fprintf(stderr, "occupancy query: %d\n", per_cu); }
        (void)hipGetLastError();
        grid = cus;
    }
    if (grid < 0) return;
    (void)hipMemsetAsync((char*)d_ws + WS_CTL, 0, CTL_ZERO_BYTES, stream);
    Args a{};
    for (int i = 0; i < 16; ++i) a.in[i] = (const float*)d_in[i];
    a.out = (float*)d_out; a.ws = (unsigned char*)d_ws; a.ph_lo = 0; a.ph_hi = N_PHASES;
    hipLaunchKernelGGL(mk_fwd, dim3(grid), dim3(NWAVES * 64), LDS_BYTES, stream, a);
}
```

```cpp
#include <hip/hip_runtime.h>
#include <hip/hip_bf16.h>
#include <cmath>
#include <cstdio>
#include <cstdint>
constexpr int NWAVES = 8;
constexpr int BATCH = 4, T = 8192, D = 1024, M = BATCH * T;
constexpr int NCHUNK = T / 64;
constexpr int IN_W = 3384, NPROJ = 3584;
constexpr float LN_EPS = 1e-5f;
constexpr float ALPHA = 1.189207115002721f;
constexpr float IDX_SCALE = 0.0625f;
constexpr float QK_C2 = 0.125f * 1.4426950408889634f;
constexpr size_t MiB = 1u << 20;
constexpr size_t WS_CTL = 0, CTL_ZERO_BYTES = 1 * MiB;
constexpr size_t WS_COS64 = 1 * MiB, WS_SIN64 = 2 * MiB, WS_COS32 = 3 * MiB, WS_SIN32 = 3 * MiB + 512 * 1024;
constexpr size_t WS_MOE = 4 * MiB;
constexpr size_t WS_WIN = 8 * MiB, WS_WO = 15 * MiB, WS_WEI = 32 * MiB, WS_WEO = 96 * MiB;
constexpr size_t WS_XB = 128 * MiB;
constexpr size_t WS_AQ = 192 * MiB, WS_AK = 224 * MiB, WS_AV = 256 * MiB;
constexpr size_t WS_IQ = 288 * MiB, WS_IK = 304 * MiB, WS_IW = 306 * MiB, WS_BG = 307 * MiB;
constexpr size_t WS_BQ = 312 * MiB, WS_BK = 328 * MiB, WS_BV = 344 * MiB, WS_BR = 376 * MiB;
constexpr size_t WS_MASK = 408 * MiB, WS_Y = 440 * MiB, WS_DEC = 504 * MiB;
constexpr size_t WS_HB = 128 * MiB, WS_XS = 192 * MiB, WS_HMID = 336 * MiB, WS_FFN2 = 192 * MiB;
constexpr size_t OUT_KVT = 0, OUT_SPREV = 64 * MiB;
constexpr int CW_TMO = 0, CW_CODE = 1, CW_BAR = 4096;
constexpr int RING_OFF = 0, RING_BYTES = 131072;
constexpr int LDSCTL_OFF = RING_BYTES, MISC_OFF = LDSCTL_OFF + 320;
constexpr int LDS_BYTES = 147456;

#define GAS __attribute__((address_space(1)))
#define LAS __attribute__((address_space(3)))
typedef unsigned short bf16;
typedef unsigned v4u __attribute__((ext_vector_type(4)));
typedef unsigned v2u __attribute__((ext_vector_type(2)));
typedef float f32x4 __attribute__((ext_vector_type(4)));
typedef float f32x2 __attribute__((ext_vector_type(2)));
typedef short bf16x8 __attribute__((ext_vector_type(8)));
typedef short s16x4 __attribute__((ext_vector_type(4)));
typedef GAS unsigned gu32;
#define RLX_AGENT __ATOMIC_RELAXED, __HIP_MEMORY_SCOPE_AGENT
#define LDS_WAIT() asm volatile("s_waitcnt lgkmcnt(0)" ::: "memory")
#define VM_WAIT() asm volatile("s_waitcnt vmcnt(0)" ::: "memory")
__device__ __forceinline__ unsigned f2bf(float f) { unsigned u = __builtin_bit_cast(unsigned, f); return (u + 0x7fffu + ((u >> 16) & 1u)) >> 16; }
__device__ __forceinline__ unsigned pk2(float lo, float hi) { return f2bf(lo) | (f2bf(hi) << 16); }
__device__ __forceinline__ float bf2f(unsigned short b) { return __builtin_bit_cast(float, (unsigned)b << 16); }
__device__ __forceinline__ unsigned pkh2(float lo, float hi) { const _Float16 a = (_Float16)lo, b = (_Float16)hi; return (unsigned)__builtin_bit_cast(unsigned short, a) | ((unsigned)__builtin_bit_cast(unsigned short, b) << 16); }
struct Args { const float* in[16]; float* out; unsigned char* ws; int ph_lo, ph_hi; };
namespace pg8 {
#define PG8_LAS __attribute__((address_space(3)))
typedef unsigned short bf16_t;
typedef short bf16x8 __attribute__((ext_vector_type(8)));
typedef float f32x4 __attribute__((ext_vector_type(4)));
typedef unsigned u32x4 __attribute__((ext_vector_type(4)));
constexpr int BM = 256, BK = 64, HALF = 128, HTB = HALF * BK * 2  , STAGE_BYTES = 8 * HTB, NXCD = 8, WGM = 8;

__host__ __device__ __forceinline__ int lds_byte(int r, int c) { const int st = (r >> 4) * 2 + (c >> 5), rr = r & 15, cc = c & 31, ob = rr * 64 + cc * 2; return st * 1024 + (ob ^ (((ob >> 9) & 1) << 5)); }
__host__ __device__ __forceinline__ void stage_rc(int b, int& R, int& C) { const int st = b / 1024, sb = b % 1024, swz = sb ^ (((sb >> 9) & 1) << 5); R = (st >> 1) * 16 + swz / 64; C = (st & 1) * 32 + (swz % 64) / 2; }
__host__ __device__ __forceinline__ int perm32(int rho) { const int n = rho >> 4, i = rho & 15; return 8 * (i >> 2) + 4 * n + (i & 3); }

struct Unit { int pm, pn; };
struct Gemm { const bf16_t* A; const bf16_t* Bt; int M, N, K; };

struct StaticOrder {
    int nM, nN, nwg, G, c;
    __host__ __device__ void init(int M, int N, int G_, int c_) { nM = M / BM; nN = N / BM; nwg = nM * nN; G = G_; c = c_; }
    __host__ __device__ bool next(int i, Unit& u) const {
        const long L = (long)i * G + c; if (L >= nwg) return false;
        int wgid = (int)L; { const int q = nwg / NXCD, r = nwg % NXCD, xcd = wgid % NXCD, off = wgid / NXCD; wgid = (xcd < r ? xcd * (q + 1) : r * (q + 1) + (xcd - r) * q) + off; }
        const int nig = WGM * nN, gid = wgid / nig, fm = gid * WGM, gsz = (nM - fm) < WGM ? (nM - fm) : WGM;
        u.pm = fm + ((wgid % nig) % gsz); u.pn = (wgid % nig) / gsz; return true;
    }
    __device__ __forceinline__ void a_ready(const Unit&) const {}
    __device__ __forceinline__ void done(const Unit&) const {}
};

__device__ __forceinline__ unsigned cvt_pk_bf16(float lo, float hi) { unsigned r; asm volatile("v_cvt_pk_bf16_f32 %0, %1, %2" : "=v"(r) : "v"(lo), "v"(hi)); return r; }
typedef float f32x2 __attribute__((ext_vector_type(2)));
__device__ __forceinline__ f32x2 gelu_pk(f32x2 v) {
    const f32x2 av = __builtin_elementwise_abs(v), d = av * 0.2316418882f + 1.0f;
    f32x2 t; t.x = __builtin_amdgcn_rcpf(d.x); t.y = __builtin_amdgcn_rcpf(d.y);
    f32x2 q = t * 0.5307027145f + (-0.7265760135f); q = q * t + 0.7107068705f; q = q * t + (-0.142248368f); q = q * t + 0.127414796f; q = q * t;
    const f32x2 s = (v * v) * (-0.72134752044f);
    f32x2 e; e.x = __builtin_amdgcn_exp2f(s.x); e.y = __builtin_amdgcn_exp2f(s.y);
    const f32x2 m = v * (q * e), r = v - m;
    f32x2 o; o.x = v.x < 0.f ? m.x : r.x; o.y = v.y < 0.f ? m.y : r.y; return o;
}

template <int ACT  > struct EpiBf16 {
    static constexpr bool PERM = true, AFTER_DRAIN = false; static_assert(ACT == 0 || ACT == 1, "EpiBf16: ACT is 0 (none) or 1 (gelu_pk)");
    bf16_t* O; int ldc; const float* bias; int split_cols; size_t split_stride; float scale0;
    __device__ __forceinline__ void operator()(const f32x4 (&acc)[2][2][4][2], const Unit& u, int wr, int wc, int fr, int fq) const {
        const int row0 = u.pm * BM + wr * 64 + fr; int colt = u.pn * BM; bf16_t* base = O;
        float sc = 1.f; if (split_cols) { const int t = colt / split_cols; base += (size_t)t * split_stride; colt -= t * split_cols; if (t == 0) sc = scale0; }
        const int col0 = colt + wc * 32 + 8 * fq, bcol0 = u.pn * BM + wc * 32 + 8 * fq;
        f32x4 bv[2][2];
#pragma unroll
        for (int bj = 0; bj < 2; ++bj)
#pragma unroll
            for (int n = 0; n < 2; ++n) bv[bj][n] = bias ? *(const f32x4*)(bias + bcol0 + bj * HALF + 4 * n) : (f32x4){0.f, 0.f, 0.f, 0.f};
#pragma unroll
        for (int ai = 0; ai < 2; ++ai)
#pragma unroll
            for (int m = 0; m < 4; ++m) { bf16_t* rowp = base + (size_t)(row0 + ai * HALF + m * 16) * ldc + col0;
#pragma unroll
                for (int bj = 0; bj < 2; ++bj) { f32x4 v0 = acc[ai][bj][m][0] + bv[bj][0], v1 = acc[ai][bj][m][1] + bv[bj][1];
                    if (ACT == 1) { f32x2 a = gelu_pk((f32x2){v0[0], v0[1]}), b = gelu_pk((f32x2){v0[2], v0[3]}), c = gelu_pk((f32x2){v1[0], v1[1]}), d = gelu_pk((f32x2){v1[2], v1[3]});
                        v0 = (f32x4){a.x, a.y, b.x, b.y}; v1 = (f32x4){c.x, c.y, d.x, d.y}; }
                    v0 = v0 * sc; v1 = v1 * sc; u32x4 w; w.x = cvt_pk_bf16(v0[0], v0[1]); w.y = cvt_pk_bf16(v0[2], v0[3]); w.z = cvt_pk_bf16(v1[0], v1[1]); w.w = cvt_pk_bf16(v1[2], v1[3]);
                    *(u32x4*)(rowp + bj * HALF) = w; } }
    }
};

struct PanelStats {
    unsigned* xbuf;
    unsigned* cnt;
    unsigned* tmo;
    int ntn; float eps;
    unsigned code;
    __device__ __forceinline__ bool run(const f32x4 (&v)[2][2][4][2], const Unit& u, int wr, int wc, int fr, int fq, PG8_LAS unsigned char* lds, int wid, int lane) const {
        typedef float f32x2v __attribute__((ext_vector_type(2)));
        PG8_LAS f32x2v* P = (PG8_LAS f32x2v*)lds;
        PG8_LAS f32x2v* S = (PG8_LAS f32x2v*)(lds + 8192);
        PG8_LAS unsigned* flag = (PG8_LAS unsigned*)(lds + 8192 + 2048);
#pragma unroll
        for (int ai = 0; ai < 2; ++ai)
#pragma unroll
            for (int m = 0; m < 4; ++m) {
                float s = 0.f;
#pragma unroll
                for (int bj = 0; bj < 2; ++bj)
#pragma unroll
                    for (int n = 0; n < 2; ++n) { const f32x4 x = v[ai][bj][m][n]; s += (x[0] + x[1]) + (x[2] + x[3]); }
                s += __shfl_xor(s, 16); s += __shfl_xor(s, 32);
                const float mw = s * (1.0f / 64.0f); float q = 0.f;
#pragma unroll
                for (int bj = 0; bj < 2; ++bj)
#pragma unroll
                    for (int n = 0; n < 2; ++n) { const f32x4 d = v[ai][bj][m][n] - mw; q += (d[0] * d[0] + d[1] * d[1]) + (d[2] * d[2] + d[3] * d[3]); }
                q += __shfl_xor(q, 16); q += __shfl_xor(q, 32);
                if (fq == 0) P[(ai * HALF + wr * 64 + m * 16 + fr) * 4 + wc] = (f32x2v){mw, q};
            }
        asm volatile("s_waitcnt lgkmcnt(0)" ::: "memory"); __builtin_amdgcn_s_barrier(); asm volatile("" ::: "memory");
#if defined(BROKEN_EXCHANGE_NO_WAIT)
#warning BROKEN CONTROL BUILD: the row-statistics exchange does not wait; results are wrong by design
        if (blockIdx.x >= 64) { const long long t0_ = clock64(); while (clock64() - t0_ < 60000) __builtin_amdgcn_s_sleep(8); }
#endif
        const int row = wid * 32 + (lane & 31);
        if (lane < 32) {
            const f32x2v a = P[row * 4 + 0], b = P[row * 4 + 1], c = P[row * 4 + 2], d = P[row * 4 + 3];
            const float mt = (a.x + b.x + c.x + d.x) * 0.25f;
            const float da = a.x - mt, db = b.x - mt, dc = c.x - mt, dd = d.x - mt;
            const float m2 = (a.y + b.y) + (c.y + d.y) + 64.0f * ((da * da + db * db) + (dc * dc + dd * dd));
            unsigned long long* slot = (unsigned long long*)xbuf + ((size_t)(u.pm * BM + row) * 4 + u.pn);
            __hip_atomic_store(slot, ((unsigned long long)__float_as_uint(m2) << 32) | __float_as_uint(mt), __ATOMIC_RELAXED, __HIP_MEMORY_SCOPE_AGENT);
        }
        asm volatile("s_waitcnt vmcnt(0)" ::: "memory");
        if (lane == 0) __hip_atomic_fetch_add(cnt + 64 * u.pm, 1u, __ATOMIC_RELAXED, __HIP_MEMORY_SCOPE_AGENT);
        if (wid == 0) {
            bool dead = false; const unsigned long long t0 = __builtin_amdgcn_s_memrealtime(); const unsigned want = 8u * (unsigned)ntn;
            for (;;) {
#if defined(BROKEN_EXCHANGE_NO_WAIT)
                break;
#endif
                if ((unsigned)__builtin_amdgcn_readfirstlane(__hip_atomic_load(cnt + 64 * u.pm, __ATOMIC_RELAXED, __HIP_MEMORY_SCOPE_AGENT)) >= want) break;
                if (__builtin_amdgcn_s_memrealtime() - t0 > 2000000ull) {
                    if (lane == 0) { unsigned expect = 0u; __hip_atomic_compare_exchange_strong(tmo + 1, &expect, code | (unsigned)(u.pm & 0xff), __ATOMIC_RELAXED, __ATOMIC_RELAXED, __HIP_MEMORY_SCOPE_AGENT);
                                     __hip_atomic_store(tmo, 1u, __ATOMIC_RELAXED, __HIP_MEMORY_SCOPE_AGENT); }
                    dead = true; break; }
                __builtin_amdgcn_s_sleep(2);
            }
            __builtin_amdgcn_fence(__ATOMIC_ACQUIRE, "agent");
            if (lane == 0) flag[0] = dead ? 1u : 0u;
        }
        asm volatile("s_waitcnt vmcnt(0) lgkmcnt(0)" ::: "memory"); __builtin_amdgcn_s_barrier(); asm volatile("" ::: "memory");
        const bool bad = flag[0] != 0u;
        if (lane < 32) {
            const unsigned long long* slot = (const unsigned long long*)xbuf + (size_t)(u.pm * BM + row) * 4; float mt[4], m2[4]; float ms = 0.f;
#pragma unroll
            for (int t = 0; t < 4; ++t) { if (t < ntn) { const unsigned long long w = __hip_atomic_load(slot + t, __ATOMIC_RELAXED, __HIP_MEMORY_SCOPE_AGENT); mt[t] = __uint_as_float((unsigned)w); m2[t] = __uint_as_float((unsigned)(w >> 32)); } else { mt[t] = 0.f; m2[t] = 0.f; } ms += mt[t]; }
            const float mean = ms / (float)ntn; float q = 0.f;
#pragma unroll
            for (int t = 0; t < 4; ++t) if (t < ntn) { const float dm = mt[t] - mean; q += m2[t] + 256.0f * dm * dm; }
            S[row] = (f32x2v){mean, 1.0f / sqrtf(q / (256.0f * (float)ntn) + eps)};
        }
        asm volatile("s_waitcnt lgkmcnt(0)" ::: "memory"); __builtin_amdgcn_s_barrier(); asm volatile("" ::: "memory");
        return bad;
    }
};
struct EpiLnRes {
    static constexpr bool PERM = false, AFTER_DRAIN = true;
    const float* base; float* out; int ldc; const float* bias; PanelStats st; unsigned poison;
    __device__ __forceinline__ void fused(f32x4 (&acc)[2][2][4][2], const Unit& u, int wr, int wc, int fr, int fq, PG8_LAS unsigned char* lds, int wid, int lane) const {
        typedef float f32x2v __attribute__((ext_vector_type(2)));
        const PG8_LAS f32x2v* S = (const PG8_LAS f32x2v*)(lds + 8192);
        const int col0 = u.pn * BM + wc * 32 + 4 * fq;
#pragma unroll
        for (int bj = 0; bj < 2; ++bj)
#pragma unroll
            for (int n = 0; n < 2; ++n) { const f32x4 bv = bias ? *(const f32x4*)(bias + col0 + bj * HALF + n * 16) : (f32x4){0.f, 0.f, 0.f, 0.f};
#pragma unroll
                for (int ai = 0; ai < 2; ++ai)
#pragma unroll
                    for (int m = 0; m < 4; ++m) acc[ai][bj][m][n] += bv; }
        f32x4 pre[4][2][2];
#pragma unroll
        for (int m = 0; m < 4; ++m) { const size_t off = (size_t)(u.pm * BM + wr * 64 + m * 16 + fr) * ldc + col0;
#pragma unroll
            for (int bj = 0; bj < 2; ++bj)
#pragma unroll
                for (int n = 0; n < 2; ++n) pre[m][bj][n] = *(const f32x4*)(base + off + bj * HALF + n * 16); }
        const bool bad = st.run(acc, u, wr, wc, fr, fq, lds, wid, lane) || poison != 0u;
        const float qnan = __builtin_nanf("");
#pragma unroll
        for (int ai = 0; ai < 2; ++ai)
#pragma unroll
            for (int m = 0; m < 4; ++m) { const int r = ai * HALF + wr * 64 + m * 16 + fr; const f32x2v sr = S[r]; const size_t off = (size_t)(u.pm * BM + r) * ldc + col0;
#pragma unroll
                for (int bj = 0; bj < 2; ++bj)
#pragma unroll
                    for (int n = 0; n < 2; ++n) { const f32x4 bs = ai == 0 ? pre[m][bj][n] : *(const f32x4*)(base + off + bj * HALF + n * 16); f32x4 o = bs + (acc[ai][bj][m][n] - sr.x) * sr.y;
                        if (bad) o = (f32x4){qnan, qnan, qnan, qnan}; *(f32x4*)(out + off + bj * HALF + n * 16) = o; }
                if (m & 1) asm volatile("" ::: "memory"); }
    }
};
struct EpiLnResLn {
    static constexpr bool PERM = false, AFTER_DRAIN = true;
    const float* base; float* out; bf16_t* xn; int ldc; const float* bias; PanelStats st1, st2; unsigned poison;
    __device__ __forceinline__ void fused(f32x4 (&acc)[2][2][4][2], const Unit& u, int wr, int wc, int fr, int fq, PG8_LAS unsigned char* lds, int wid, int lane) const {
        typedef float f32x2v __attribute__((ext_vector_type(2))); typedef unsigned u32x2v __attribute__((ext_vector_type(2)));
        const PG8_LAS f32x2v* S = (const PG8_LAS f32x2v*)(lds + 8192);
        const int col0 = u.pn * BM + wc * 32 + 4 * fq;
#pragma unroll
        for (int bj = 0; bj < 2; ++bj)
#pragma unroll
            for (int n = 0; n < 2; ++n) { const f32x4 bv = bias ? *(const f32x4*)(bias + col0 + bj * HALF + n * 16) : (f32x4){0.f, 0.f, 0.f, 0.f};
#pragma unroll
                for (int ai = 0; ai < 2; ++ai)
#pragma unroll
                    for (int m = 0; m < 4; ++m) acc[ai][bj][m][n] += bv; }
        bool bad = st1.run(acc, u, wr, wc, fr, fq, lds, wid, lane) || poison != 0u;
        const float qnan = __builtin_nanf("");
#pragma unroll
        for (int ai = 0; ai < 2; ++ai)
#pragma unroll
            for (int m = 0; m < 4; ++m) { const int r = ai * HALF + wr * 64 + m * 16 + fr; const f32x2v sr = S[r]; const size_t off = (size_t)(u.pm * BM + r) * ldc + col0;
#pragma unroll
                for (int bj = 0; bj < 2; ++bj)
#pragma unroll
                    for (int n = 0; n < 2; ++n) { const f32x4 bs = *(const f32x4*)(base + off + bj * HALF + n * 16); acc[ai][bj][m][n] = bs + (acc[ai][bj][m][n] - sr.x) * sr.y; }
                asm volatile("" : "+v"(acc[ai][0][m][0]), "+v"(acc[ai][0][m][1]), "+v"(acc[ai][1][m][0]), "+v"(acc[ai][1][m][1]));
                if (m & 1) asm volatile("" ::: "memory"); }
        const bool bad1 = bad;
        bad = st2.run(acc, u, wr, wc, fr, fq, lds, wid, lane) || bad;
#pragma unroll
        for (int ai = 0; ai < 2; ++ai)
#pragma unroll
            for (int m = 0; m < 4; ++m) { const int r = ai * HALF + wr * 64 + m * 16 + fr; const f32x2v sr = S[r]; const size_t off = (size_t)(u.pm * BM + r) * ldc + col0;
#pragma unroll
                for (int bj = 0; bj < 2; ++bj)
#pragma unroll
                    for (int n = 0; n < 2; ++n) { const f32x4 x1 = acc[ai][bj][m][n]; *(f32x4*)(out + off + bj * HALF + n * 16) = bad1 ? (f32x4){qnan, qnan, qnan, qnan} : x1;
                        const f32x4 o = (x1 - sr.x) * sr.y; u32x2v w; w.x = cvt_pk_bf16(o[0], o[1]); w.y = cvt_pk_bf16(o[2], o[3]);
                        if (bad) { w.x = 0x7fc07fc0u; w.y = 0x7fc07fc0u; } *(u32x2v*)(xn + off + bj * HALF + n * 16) = w; }
                asm volatile("" ::: "memory"); }
    }
};

template <class Epi, class Sched, bool ALIGN_EPI = false, bool SP2 = false>
__device__ __forceinline__ void gemm_phase(PG8_LAS unsigned char* lds, const Gemm g, const Sched& S, const Epi& E) {
    const int tid = threadIdx.x, wid = __builtin_amdgcn_readfirstlane(tid >> 6), lane = tid & 63, wr = wid >> 2, wc = wid & 3, fr = lane & 15, fq = lane >> 4;
    const int K = g.K, nt = K / BK;
    unsigned voffA[2], voffB[2];
#pragma unroll
    for (int i = 0; i < 2; ++i) { int R, C; stage_rc(tid * 16 + i * 8192, R, C); const int Rb = Epi::PERM ? ((R & ~31) + perm32(R & 31)) : R;
        voffA[i] = (unsigned)(R * K + C) * 2u; voffB[i] = (unsigned)(Rb * K + C) * 2u; }
    const size_t kstep = (size_t)(BK * 2);
    const size_t hstep = (size_t)HALF * K * 2;
    const size_t tstep = 2 * hstep;
    const unsigned ldsw = (unsigned)wid * 1024u;
    const int aoff = lds_byte(wr * 64 + fr, fq * 8), boff = lds_byte(wc * 32 + fr, fq * 8);
#define PG8_SA(b, h) (((b) * 2 + (h)) * HTB)
#define PG8_SB(b, h) ((4 + (b) * 2 + (h)) * HTB)
#define PG8_STAGE(bufoff, gbase, voff) do { _Pragma("unroll") for (int _i = 0; _i < 2; ++_i) \
        __builtin_amdgcn_global_load_lds((const unsigned*)((const char*)(gbase) + (voff)[_i]), (PG8_LAS unsigned*)(lds + (bufoff) + ldsw + _i * 8192), 16, 0, 0); } while (0)
#define PG8_LDA(dst, b, h) do { _Pragma("unroll") for (int m = 0; m < 4; ++m) _Pragma("unroll") for (int k = 0; k < 2; ++k) dst[m][k] = *(const PG8_LAS bf16x8*)(lds + PG8_SA(b, h) + aoff + m * 2048 + k * 1024); } while (0)
#define PG8_LDB(dst, b, h) do { _Pragma("unroll") for (int n = 0; n < 2; ++n) _Pragma("unroll") for (int k = 0; k < 2; ++k) dst[n][k] = *(const PG8_LAS bf16x8*)(lds + PG8_SB(b, h) + boff + n * 2048 + k * 1024); } while (0)
#define PG8_MMA(ai, bj, At, Bt) do { __builtin_amdgcn_s_setprio(1); _Pragma("unroll") for (int m = 0; m < 4; ++m) _Pragma("unroll") for (int n = 0; n < 2; ++n) _Pragma("unroll") for (int k = 0; k < 2; ++k) \
        acc[ai][bj][m][n] = __builtin_amdgcn_mfma_f32_16x16x32_bf16(Bt[n][k], At[m][k], acc[ai][bj][m][n], 0, 0, 0); __builtin_amdgcn_s_setprio(0); } while (0)
#define PG8_WAIT_V(n) asm volatile("s_waitcnt vmcnt(" #n ")" ::: "memory")
#define PG8_WAIT_L(n) asm volatile("s_waitcnt lgkmcnt(" #n ")" ::: "memory")
#define PG8_BAR __builtin_amdgcn_s_barrier()
#define PG8_SCHED __builtin_amdgcn_sched_barrier(0)
    Unit cur, nxt; int ui = 0;
    if (!S.next(0, cur)) return;
    f32x4 acc[2][2][4][2];
#pragma unroll
    for (int a = 0; a < 2; ++a)
#pragma unroll
        for (int b = 0; b < 2; ++b)
#pragma unroll
            for (int m = 0; m < 4; ++m)
#pragma unroll
                for (int n = 0; n < 2; ++n) acc[a][b][m][n] = (f32x4){0.f, 0.f, 0.f, 0.f};
    bf16x8 At[4][2], B0[2][2], B1[2][2];
    const char* cA = (const char*)g.A + (size_t)cur.pm * tstep; const char* cB = (const char*)g.Bt + (size_t)cur.pn * tstep;
    S.a_ready(cur);
    if constexpr (SP2) {
        PG8_STAGE(PG8_SB(0, 0), cB, voffB); PG8_STAGE(PG8_SB(0, 1), cB + hstep, voffB); PG8_STAGE(PG8_SA(0, 0), cA, voffA); PG8_STAGE(PG8_SA(0, 1), cA + hstep, voffA);
        if (wr == 1) PG8_BAR;
        PG8_WAIT_V(2); PG8_BAR;
        PG8_STAGE(PG8_SB(1, 0), cB + kstep, voffB); PG8_STAGE(PG8_SA(1, 0), cA + kstep, voffA); PG8_STAGE(PG8_SB(1, 1), cB + hstep + kstep, voffB);
        PG8_WAIT_V(6); PG8_BAR;
    } else {
        PG8_STAGE(PG8_SB(0, 0), cB, voffB); PG8_STAGE(PG8_SA(0, 0), cA, voffA); PG8_STAGE(PG8_SB(0, 1), cB + hstep, voffB); PG8_STAGE(PG8_SA(0, 1), cA + hstep, voffA);
        if (wr == 1) PG8_BAR;
        PG8_WAIT_V(4); PG8_BAR;
        PG8_STAGE(PG8_SB(1, 0), cB + kstep, voffB); PG8_STAGE(PG8_SA(1, 0), cA + kstep, voffA); PG8_STAGE(PG8_SB(1, 1), cB + hstep + kstep, voffB);
        PG8_WAIT_V(6); PG8_BAR;
    }
    for (;;) {
        const bool has_next = S.next(ui + 1, nxt);
        const char* nA = has_next ? (const char*)g.A + (size_t)nxt.pm * tstep : cA; const char* nB = has_next ? (const char*)g.Bt + (size_t)nxt.pn * tstep : cB;
        for (int t = 0; t < nt; t += 2) {
            const bool last = (t == nt - 2);
            const char* a1 = cA + (size_t)(t + 1) * kstep;
            const char* a2 = last ? nA : cA + (size_t)(t + 2) * kstep; const char* b2 = last ? nB : cB + (size_t)(t + 2) * kstep;
            const char* a3 = a2 + kstep; const char* b3 = b2 + kstep;
            if (last && has_next) S.a_ready(nxt);
            if constexpr (SP2) {
            PG8_LDB(B0, 0, 0); PG8_LDB(B1, 0, 1); PG8_SCHED; PG8_LDA(At, 0, 0); PG8_STAGE(PG8_SA(1, 1), a1 + hstep, voffA);
            PG8_WAIT_V(8); PG8_WAIT_L(0); PG8_BAR; PG8_MMA(0, 0, At, B0); PG8_MMA(0, 1, At, B1); PG8_BAR; PG8_SCHED;
            PG8_LDA(At, 0, 1); PG8_STAGE(PG8_SB(0, 0), b2, voffB); PG8_STAGE(PG8_SB(0, 1), b2 + hstep, voffB); PG8_STAGE(PG8_SA(0, 0), a2, voffA);
            PG8_WAIT_V(8); PG8_WAIT_L(0); PG8_BAR; PG8_MMA(1, 0, At, B0); PG8_MMA(1, 1, At, B1); PG8_BAR; PG8_SCHED;
            PG8_LDB(B0, 1, 0); PG8_LDB(B1, 1, 1); PG8_SCHED; PG8_LDA(At, 1, 0); PG8_STAGE(PG8_SA(0, 1), a2 + hstep, voffA);
            PG8_WAIT_V(8); PG8_WAIT_L(0); PG8_BAR; PG8_MMA(0, 0, At, B0); PG8_MMA(0, 1, At, B1); PG8_BAR; PG8_SCHED;
            PG8_LDA(At, 1, 1); PG8_STAGE(PG8_SB(1, 0), b3, voffB); PG8_STAGE(PG8_SB(1, 1), b3 + hstep, voffB); PG8_STAGE(PG8_SA(1, 0), a3, voffA);
            PG8_WAIT_V(8); PG8_WAIT_L(0); PG8_BAR; PG8_MMA(1, 0, At, B0); PG8_MMA(1, 1, At, B1); PG8_BAR; PG8_SCHED;
            } else {
            PG8_LDB(B0, 0, 0); PG8_SCHED; PG8_LDA(At, 0, 0); PG8_STAGE(PG8_SA(1, 1), a1 + hstep, voffA);
            PG8_WAIT_L(8); PG8_BAR; PG8_WAIT_L(0); PG8_MMA(0, 0, At, B0); PG8_BAR; PG8_SCHED;
            PG8_LDB(B1, 0, 1); PG8_STAGE(PG8_SB(0, 0), b2, voffB);
            PG8_BAR; PG8_WAIT_L(0); PG8_MMA(0, 1, At, B1); PG8_BAR;
            PG8_LDA(At, 0, 1); PG8_STAGE(PG8_SA(0, 0), a2, voffA);
            PG8_BAR; PG8_WAIT_L(0); PG8_MMA(1, 0, At, B0); PG8_BAR; PG8_SCHED;
            PG8_STAGE(PG8_SB(0, 1), b2 + hstep, voffB);
            PG8_WAIT_V(6); PG8_BAR; PG8_MMA(1, 1, At, B1); PG8_BAR;
            PG8_LDB(B0, 1, 0); PG8_SCHED; PG8_LDA(At, 1, 0); PG8_STAGE(PG8_SA(0, 1), a2 + hstep, voffA);
            PG8_WAIT_L(8); PG8_BAR; PG8_WAIT_L(0); PG8_MMA(0, 0, At, B0); PG8_BAR; PG8_SCHED;
            PG8_LDB(B1, 1, 1); PG8_STAGE(PG8_SB(1, 0), b3, voffB);
            PG8_BAR; PG8_WAIT_L(0); PG8_MMA(0, 1, At, B1); PG8_BAR;
            PG8_LDA(At, 1, 1); PG8_STAGE(PG8_SA(1, 0), a3, voffA);
            PG8_BAR; PG8_WAIT_L(0); PG8_MMA(1, 0, At, B0); PG8_BAR; PG8_SCHED;
            PG8_STAGE(PG8_SB(1, 1), b3 + hstep, voffB);
            PG8_WAIT_V(6); PG8_BAR; PG8_MMA(1, 1, At, B1); PG8_BAR;
            }
        }
        if constexpr (ALIGN_EPI) { if (wr == 0) PG8_BAR; }
        if constexpr (!Epi::AFTER_DRAIN) { E(acc, cur, wr, wc, fr, fq); S.done(cur); }
        if (!has_next) break;
#pragma unroll
        for (int a = 0; a < 2; ++a)
#pragma unroll
            for (int b = 0; b < 2; ++b)
#pragma unroll
                for (int m = 0; m < 4; ++m)
#pragma unroll
                    for (int n = 0; n < 2; ++n) acc[a][b][m][n] = (f32x4){0.f, 0.f, 0.f, 0.f};
        cur = nxt; cA = nA; cB = nB; ++ui;
        if constexpr (ALIGN_EPI) { if (wr == 1) PG8_BAR; }
    }
    PG8_WAIT_V(0);
    if constexpr (!ALIGN_EPI) { if (wr == 0) PG8_BAR; }
    PG8_BAR;
    if constexpr (Epi::AFTER_DRAIN) { E.fused(acc, cur, wr, wc, fr, fq, lds, wid, lane); S.done(cur); }
#undef PG8_SA
#undef PG8_SB
#undef PG8_STAGE
#undef PG8_LDA
#undef PG8_LDB
#undef PG8_MMA
#undef PG8_WAIT_V
#undef PG8_WAIT_L
#undef PG8_BAR
#undef PG8_SCHED
}
}
#define XB_TMO      128
#define XB_XCNT(j)  (256  + 64 * (j))
#define XB_XSUB(j)  (1280 + 64 * (j))
#define XB_XGEN(j)  (2304 + 64 * (j))
#define XB_TOP      3328
#define XB_TOPGEN   3392
#define XCD_BAR_WORDS 3456
#define XB_SPIN_CAP (1u << 18)

__device__ __forceinline__ unsigned xb_ld(unsigned* p)              { return __hip_atomic_load(p, __ATOMIC_RELAXED, __HIP_MEMORY_SCOPE_AGENT); }
__device__ __forceinline__ unsigned xb_add(unsigned* p, unsigned v) { return __hip_atomic_fetch_add(p, v, __ATOMIC_RELAXED, __HIP_MEMORY_SCOPE_AGENT); }
__device__ __forceinline__ unsigned xb_xcc_id() { return (unsigned)__builtin_amdgcn_s_getreg((3 << 11) | 20) & 0xFu; }
#define XB_SPIN(cond, bar) do { unsigned _sp = 0; while (cond) { __builtin_amdgcn_s_sleep(1); \
    if ((++_sp & 255u) == 0u) { if (xb_ld(&(bar)[XB_TMO])) break; if (_sp > XB_SPIN_CAP) { atomicAdd(&(bar)[XB_TMO], 1u); break; } } } } while (0)

struct XcdBarrier {
    unsigned* bar; unsigned x;
    volatile LAS unsigned* st;
};

__device__ __forceinline__ XcdBarrier xcd_barrier_post(unsigned* bar, volatile LAS unsigned* st) {
    XcdBarrier b; b.bar = bar; b.x = xb_xcc_id(); b.st = st;
    if (threadIdx.x == 0) (void)xb_add(&bar[XB_XCNT(b.x)], 1u);
    return b;
}
__device__ __forceinline__ void xcd_barrier_complete(unsigned* bar, unsigned x, unsigned& nloc, unsigned& nx) {
    const unsigned G = gridDim.x * gridDim.y * gridDim.z;
    unsigned sum, cnt, mine, sp = 0u;
    for (;;) {
        sum = 0u; cnt = 0u; mine = 0u;
#pragma unroll
        for (unsigned j = 0; j < 16; ++j) { const unsigned c = xb_ld(&bar[XB_XCNT(j)]); sum += c; cnt += (c > 0u) ? 1u : 0u; mine = (j == x) ? c : mine; }
        if (sum == G) break;
        __builtin_amdgcn_s_sleep(1);
        if ((++sp & 255u) == 0u) { if (xb_ld(&bar[XB_TMO])) break; if (sp > XB_SPIN_CAP) { atomicAdd(&bar[XB_TMO], 1u); break; } }
    }
    nloc = mine > 0u ? mine : 1u; nx = cnt > 0u ? cnt : 1u;
}

__device__ __forceinline__ void xcd_barrier(const XcdBarrier& b) {
    asm volatile("s_waitcnt vmcnt(0)" ::: "memory");
    __syncthreads();
    if (threadIdx.x == 0) {
        unsigned* bar = b.bar;
        __builtin_amdgcn_s_waitcnt(0);
        unsigned nloc = b.st[0], nx = b.st[1];
        if (nloc == 0u) { xcd_barrier_complete(bar, b.x, nloc, nx); b.st[0] = nloc; b.st[1] = nx; }
        const unsigned old = xb_add(&bar[XB_XSUB(b.x)], 1u);
        const unsigned gen = old / nloc;
        if (old + 1u == (gen + 1u) * nloc) {
            __builtin_amdgcn_fence(__ATOMIC_RELEASE, "agent");
            asm volatile("s_waitcnt vmcnt(0)" ::: "memory");
            const unsigned og = xb_add(&bar[XB_TOP], 1u);
            const unsigned tg = og / nx;
            if (og + 1u == (tg + 1u) * nx) xb_add(&bar[XB_TOPGEN], 1u);
            else XB_SPIN(xb_ld(&bar[XB_TOPGEN]) == tg, bar);
            __builtin_amdgcn_fence(__ATOMIC_ACQUIRE, "agent");
            xb_add(&bar[XB_XGEN(b.x)], 1u);
            asm volatile("s_waitcnt vmcnt(0)" ::: "memory");
        } else {
            XB_SPIN(xb_ld(&bar[XB_XGEN(b.x)]) == gen, bar);
            __builtin_amdgcn_fence(__ATOMIC_ACQUIRE, "agent");
            asm volatile("s_waitcnt vmcnt(0)" ::: "memory");
        }
    }
    __syncthreads();
}
struct Frame {
    LAS unsigned char* lds;
    volatile LAS unsigned* MISC;
    gu32* ctl;
    int tid, lane, wave;
    int vcu, G;
};
template <int CTRL> __device__ __forceinline__ float dpp_f(float v) { return __builtin_bit_cast(float, __builtin_amdgcn_update_dpp(0, __builtin_bit_cast(int, v), CTRL, 0xf, 0xf, true)); }
__device__ __forceinline__ float wave_sum(float v) {
    v += dpp_f<0xB1>(v); v += dpp_f<0x4E>(v); v += dpp_f<0x141>(v); v += dpp_f<0x140>(v);
    { const auto s = __builtin_amdgcn_permlane16_swap(__float_as_uint(v), __float_as_uint(v), false, false); v = __uint_as_float(s[0]) + __uint_as_float(s[1]); }
    { const auto s = __builtin_amdgcn_permlane32_swap(__float_as_uint(v), __float_as_uint(v), false, false); v = __uint_as_float(s[0]) + __uint_as_float(s[1]); }
    return v;
}
__device__ __forceinline__ float rdlane(float v, int l) { return __builtin_bit_cast(float, __builtin_amdgcn_readlane(__builtin_bit_cast(int, v), l)); }
__device__ __forceinline__ float silu_f(float x) { return x / (1.f + __expf(-x)); }

__device__ __forceinline__ int win_src(int n) {
    if (n < 1024) { const int seg = n >> 9, c = n & 511, head = c >> 6, cc = c & 63; return seg * 512 + head * 64 + (cc >> 1) + 32 * (cc & 1); }
    if (n < 1536) return n;
    if (n < 1792) { const int c = n - 1536, head = c >> 5, cc = c & 31; return 1536 + head * 32 + (cc >> 1) + 16 * (cc & 1); }
    if (n < 2048) return 1832 + (n - 1792);
    if (n < 2304) return 2088 + (n - 2048);
    if (n < 2816) return 2344 + (n - 2304);
    if (n < 3328) return 2856 + (n - 2816);
    if (n < 3360) { const int cc = n - 3328; return 1792 + (cc >> 1) + 16 * (cc & 1); }
    if (n < 3368) return 1824 + (n - 3360);
    if (n < 3384) return n;
    return -1;
}
__device__ __forceinline__ int ei_src(int n) { return (n & 4) ? 512 + 4 * (n >> 3) + (n & 3) : 4 * (n >> 3) + (n & 3); }
template <int MODE> __device__ __forceinline__ void p0_transpose_item(const float* W, int K, int N, bf16* WT, LAS float* scr, int kb, int nb, int lane) {
    const int k0 = 64 * kb, n0 = 32 * nb;
    int sc = n0 + (lane & 31); if (MODE == 1) sc = win_src(sc); if (MODE == 2) sc = ei_src(sc);
#pragma unroll 8
    for (int i = 0; i < 32; ++i) { const int kk = 2 * i + (lane >> 5); scr[kk * 33 + (lane & 31)] = (sc >= 0) ? W[(size_t)(k0 + kk) * N + sc] : 0.f; }
    LDS_WAIT(); asm volatile("" ::: "memory");
    const int c = lane & 7;
#pragma unroll
    for (int j = 0; j < 4; ++j) { const int n = (lane >> 3) + 8 * j; const LAS float* s = scr + (8 * c) * 33 + n;
        v4u o; o.x = pk2(s[0 * 33], s[1 * 33]); o.y = pk2(s[2 * 33], s[3 * 33]); o.z = pk2(s[4 * 33], s[5 * 33]); o.w = pk2(s[6 * 33], s[7 * 33]);
        *(GAS v4u*)(WT + (size_t)(n0 + n) * K + k0 + 8 * c) = o; }
    LDS_WAIT(); asm volatile("" ::: "memory");
}
__device__ __forceinline__ void p0_prologue(Frame& F, const Args& a) {
    unsigned char* ws = a.ws;
    LAS float* scr = (LAS float*)(F.lds + RING_OFF + F.wave * 16384);
    const int gw = F.vcu * NWAVES + F.wave, NGW = F.G * NWAVES;
    constexpr int I_IN = 16 * (NPROJ / 32), I_O = 16 * 32, I_EI = 32 * 16 * 32, I_EO = 32 * 8 * 32;
    constexpr int NITEMS = I_IN + I_O + I_EI + I_EO;
    for (int it = gw; it < NITEMS; it += NGW) {
        int r = it;
        if (r < I_IN) { p0_transpose_item<1>(a.in[1], D, IN_W, (bf16*)(ws + WS_WIN), scr, r / (NPROJ / 32), r % (NPROJ / 32), F.lane); continue; } r -= I_IN;
        if (r < I_O) { p0_transpose_item<0>(a.in[5], D, D, (bf16*)(ws + WS_WO), scr, r / 32, r % 32, F.lane); continue; } r -= I_O;
        if (r < I_EI) { const int e = r / 512, q = r % 512; p0_transpose_item<2>(a.in[12] + (size_t)e * 1024 * 1024, 1024, 1024, (bf16*)(ws + WS_WEI) + (size_t)e * 1024 * 1024, scr, q / 32, q % 32, F.lane); continue; } r -= I_EI;
        { const int e = r / 256, q = r % 256; p0_transpose_item<0>(a.in[13] + (size_t)e * 512 * 1024, 512, 1024, (bf16*)(ws + WS_WEO) + (size_t)e * 1024 * 512, scr, q / 32, q % 32, F.lane); }
    }
    for (int m = gw; m < M; m += NGW) {
        const GAS f32x4* xr = (const GAS f32x4*)(a.in[0] + (size_t)m * D) + F.lane;
        GAS v2u* o8 = (GAS v2u*)((bf16*)(ws + WS_XB) + (size_t)m * D) + F.lane;
#pragma unroll
        for (int j = 0; j < 4; ++j) { const f32x4 v = xr[64 * j]; v2u w; w.x = pk2(v.x, v.y); w.y = pk2(v.z, v.w); o8[64 * j] = w; }
    }
    const int gt = F.vcu * (NWAVES * 64) + F.tid, NGT = F.G * NWAVES * 64;
    for (int i = gt; i < T * 48; i += NGT) {
        const int pos = i / 48, jj = i % 48; const bool big = jj < 32; const int j = big ? jj : jj - 32;
        const double r = big ? 0.74989420933245582730   : 0.56234132519034908039  ;
        double inv = 1.0; for (int k = 0; k < j; ++k) inv *= r;
        const double rev = (double)pos * inv * 0.15915494309189533577; const float f = (float)(rev - __builtin_floor(rev));
        const float c = __builtin_amdgcn_cosf(f), s = __builtin_amdgcn_sinf(f);
        if (big) { ((float*)(ws + WS_COS64))[pos * 32 + j] = c; ((float*)(ws + WS_SIN64))[pos * 32 + j] = s; }
        else { ((float*)(ws + WS_COS32))[pos * 16 + j] = c; ((float*)(ws + WS_SIN32))[pos * 16 + j] = s; }
    }
}
struct EpiProj {
    static constexpr bool PERM = true, AFTER_DRAIN = false;
    unsigned char* ws;
    static __device__ __forceinline__ void rope4(f32x4& v0, f32x4& v1, const f32x4 c, const f32x4 s) {
        const f32x4 a = v0, b = v1;
        v0[0] = a[0] * c[0] - a[1] * s[0]; v0[1] = a[1] * c[0] + a[0] * s[0];
        v0[2] = a[2] * c[1] - a[3] * s[1]; v0[3] = a[3] * c[1] + a[2] * s[1];
        v1[0] = b[0] * c[2] - b[1] * s[2]; v1[1] = b[1] * c[2] + b[0] * s[2];
        v1[2] = b[2] * c[3] - b[3] * s[3]; v1[3] = b[3] * c[3] + b[2] * s[3];
    }
    template <int SEG> __device__ __forceinline__ void emit(const f32x4 (&acc)[2][2][4][2], const pg8::Unit& u, int wr, int wc, int fr, int fq) const {
        const int row0 = u.pm * 256 + wr * 64 + fr;
#pragma unroll
        for (int ai = 0; ai < 2; ++ai)
#pragma unroll
            for (int m = 0; m < 4; ++m) {
                const int r = row0 + ai * 128 + m * 16, pos = r & (T - 1);
#pragma unroll
                for (int bj = 0; bj < 2; ++bj) {
                    const int cg = u.pn * 256 + bj * 128 + wc * 32 + 8 * fq;
                    f32x4 v0 = acc[ai][bj][m][0], v1 = acc[ai][bj][m][1];
                    if (SEG == 0 || SEG == 1) {
                        const int j0 = (cg & 63) >> 1;
                        const f32x4 c = *(const f32x4*)((const float*)(ws + WS_COS64) + pos * 32 + j0), s = *(const f32x4*)((const float*)(ws + WS_SIN64) + pos * 32 + j0);
                        rope4(v0, v1, c, s);
                        if (SEG == 0) { v0 = v0 * QK_C2; v1 = v1 * QK_C2; }
                        v4u w; w.x = pk2(v0[0], v0[1]); w.y = pk2(v0[2], v0[3]); w.z = pk2(v1[0], v1[1]); w.w = pk2(v1[2], v1[3]);
                        *(v4u*)((bf16*)(ws + (SEG == 0 ? WS_AQ : WS_AK)) + (size_t)r * 512 + (cg & 511)) = w;
                    } else if (SEG == 2 || SEG == 6 || SEG == 7) {
                        const size_t base = SEG == 2 ? WS_AV : (SEG == 6 ? WS_BV : WS_BR); const int c0 = SEG == 2 ? 1024 : (SEG == 6 ? 2304 : 2816);
                        v4u w; w.x = pk2(v0[0], v0[1]); w.y = pk2(v0[2], v0[3]); w.z = pk2(v1[0], v1[1]); w.w = pk2(v1[2], v1[3]);
                        *(v4u*)((bf16*)(ws + base) + (size_t)r * 512 + (cg - c0)) = w;
                    } else if (SEG == 3) {
                        const int j0 = (cg & 31) >> 1;
                        const f32x4 c = *(const f32x4*)((const float*)(ws + WS_COS32) + pos * 16 + j0), s = *(const f32x4*)((const float*)(ws + WS_SIN32) + pos * 16 + j0);
                        rope4(v0, v1, c, s);
                        v4u w; w.x = pkh2(v0[0], v0[1]); w.y = pkh2(v0[2], v0[3]); w.z = pkh2(v1[0], v1[1]); w.w = pkh2(v1[2], v1[3]);
                        *(v4u*)((unsigned short*)(ws + WS_IQ) + (size_t)r * 256 + (cg - 1536)) = w;
                    } else if (SEG == 4 || SEG == 5) {
                        if (SEG == 4) { v0 = v0 * 0.125f; v1 = v1 * 0.125f; }
                        v4u w; w.x = pk2(v0[0], v0[1]); w.y = pk2(v0[2], v0[3]); w.z = pk2(v1[0], v1[1]); w.w = pk2(v1[2], v1[3]);
                        *(v4u*)((bf16*)(ws + (SEG == 4 ? WS_BQ : WS_BK)) + (size_t)r * 256 + (cg - (SEG == 4 ? 1792 : 2048))) = w;
                    } else {
                        const int tc = cg - 3328;
                        if (tc < 32) {
                            const int j0 = tc >> 1;
                            const f32x4 c = *(const f32x4*)((const float*)(ws + WS_COS32) + pos * 16 + j0), s = *(const f32x4*)((const float*)(ws + WS_SIN32) + pos * 16 + j0);
                            rope4(v0, v1, c, s);
                            v4u w; w.x = pkh2(v0[0], v0[1]); w.y = pkh2(v0[2], v0[3]); w.z = pkh2(v1[0], v1[1]); w.w = pkh2(v1[2], v1[3]);
                            *(v4u*)((unsigned short*)(ws + WS_IK) + (size_t)r * 32 + tc) = w;
                        } else if (tc < 40) {
                            float* p = (float*)(ws + WS_IW) + (size_t)r * 8; *(f32x4*)p = v0 * IDX_SCALE; *(f32x4*)(p + 4) = v1 * IDX_SCALE;
                        } else if (tc < 56) {
                            float* p = (float*)(ws + WS_BG) + (size_t)r * 16 + (tc - 40); *(f32x4*)p = v0; *(f32x4*)(p + 4) = v1;
                        }
                    }
                }
            }
    }
    __device__ __forceinline__ void operator()(const f32x4 (&acc)[2][2][4][2], const pg8::Unit& u, int wr, int wc, int fr, int fq) const {
        switch (u.pn) {
            case 0: case 1: emit<0>(acc, u, wr, wc, fr, fq); break;
            case 2: case 3: emit<1>(acc, u, wr, wc, fr, fq); break;
            case 4: case 5: emit<2>(acc, u, wr, wc, fr, fq); break;
            case 6: emit<3>(acc, u, wr, wc, fr, fq); break;
            case 7: emit<4>(acc, u, wr, wc, fr, fq); break;
            case 8: emit<5>(acc, u, wr, wc, fr, fq); break;
            case 9: case 10: emit<6>(acc, u, wr, wc, fr, fq); break;
            case 11: case 12: emit<7>(acc, u, wr, wc, fr, fq); break;
            default: emit<8>(acc, u, wr, wc, fr, fq); break;
        }
    }
};
struct EpiMixBf16 {
    static constexpr bool PERM = true, AFTER_DRAIN = false;
    bf16* C;
    __device__ __forceinline__ void operator()(const f32x4 (&acc)[2][2][4][2], const pg8::Unit& u, int wr, int wc, int fr, int fq) const {
        const int row0 = u.pm * 256 + wr * 64 + fr, col0 = u.pn * 256 + wc * 32 + 8 * fq;
#pragma unroll
        for (int ai = 0; ai < 2; ++ai)
#pragma unroll
            for (int m = 0; m < 4; ++m) { bf16* rowp = C + (size_t)(row0 + ai * 128 + m * 16) * 1024 + col0;
#pragma unroll
                for (int bj = 0; bj < 2; ++bj) { const f32x4 v0 = acc[ai][bj][m][0], v1 = acc[ai][bj][m][1];
                    v4u w; w.x = pk2(v0[0], v0[1]); w.y = pk2(v0[2], v0[3]); w.z = pk2(v1[0], v1[1]); w.w = pk2(v1[2], v1[3]);
                    *(v4u*)(rowp + bj * 128) = w; } }
    }
};
constexpr int GL_GT = 0, GL_RS = 2048, GL_QG = 4096, GL_KG = GL_QG + 9216, GL_KD = GL_KG + 9216, GL_V = 32768;
constexpr int GL_S64 = 144, GL_SV = 272;
typedef short v4i16_t __attribute__((ext_vector_type(4)));
__device__ __forceinline__ bf16x8 tr_frag(LAS const unsigned char* img, int stride, int r0a, int r0b, int c0, int lane) {
    const int q = (lane & 15) >> 2, p = lane & 3;
    const s16x4 lo = __builtin_bit_cast(s16x4, __builtin_amdgcn_ds_read_tr16_b64_v4i16((LAS v4i16_t*)(img + (r0a + q) * stride + (c0 + 4 * p) * 2)));
    const s16x4 hi = __builtin_bit_cast(s16x4, __builtin_amdgcn_ds_read_tr16_b64_v4i16((LAS v4i16_t*)(img + (r0b + q) * stride + (c0 + 4 * p) * 2)));
    return (bf16x8){lo[0], lo[1], lo[2], lo[3], hi[0], hi[1], hi[2], hi[3]};
}
struct GlaRaw { float w[16]; float bias, bv0, bv1; unsigned short k[8], q[8]; v4u v[2]; };
template <bool WITH_Q> __device__ __forceinline__ void gla_fetch(const Args& a, int uu, int tid, int lane, int g, GlaRaw& R) {
    const int h = uu & 3, t0 = (uu >> 2) * 64, d = tid & 63;
    const float* Wg = a.in[2]; const float* BG = (const float*)(a.ws + WS_BG);
    const bf16* BQ = (const bf16*)(a.ws + WS_BQ); const bf16* BK = (const bf16*)(a.ws + WS_BK); const bf16* BV = (const bf16*)(a.ws + WS_BV);
#pragma unroll
    for (int r = 0; r < 16; ++r) R.w[r] = Wg[r * 256 + h * 64 + d];
    R.bias = a.in[3][h * 64 + d];
    R.bv0 = BG[(size_t)(t0 + 8 * g + (lane >> 4)) * 16 + (lane & 15)];
    R.bv1 = BG[(size_t)(t0 + 8 * g + 4 + (lane >> 4)) * 16 + (lane & 15)];
#pragma unroll
    for (int jj = 0; jj < 8; ++jj) { R.k[jj] = BK[(size_t)(t0 + 8 * g + jj) * 256 + h * 64 + d]; if (WITH_Q) R.q[jj] = BQ[(size_t)(t0 + 8 * g + jj) * 256 + h * 64 + d]; }
#pragma unroll
    for (int i = 0; i < 2; ++i) { const int p = tid + 512 * i, row = p >> 4, cp = p & 15; R.v[i] = *(const v4u*)(BV + (size_t)(t0 + row) * 512 + h * 128 + cp * 8); }
}
__device__ __forceinline__ void gla_gate(const GlaRaw& R, LAS float* GT, int tid, int g, float (&b)[8], float& blast) {
    const int d = tid & 63;
    float run = 0.f;
#pragma unroll
    for (int jj = 0; jj < 8; ++jj) {
        float z = R.bias;
#pragma unroll
        for (int r = 0; r < 16; ++r) z += rdlane(jj < 4 ? R.bv0 : R.bv1, (jj & 3) * 16 + r) * R.w[r];
        z = fmaxf(z, -80.f);
        const float la = -__logf(1.f + __expf(-z)) * (1.f / 16.f);
        run += la; b[jj] = run;
    }
    GT[g * 64 + d] = run;
    __syncthreads();
    float off = 0.f, tot = 0.f;
#pragma unroll
    for (int gg = 0; gg < 8; ++gg) { const float v = GT[gg * 64 + d]; tot += v; if (gg < g) off += v; }
#pragma unroll
    for (int jj = 0; jj < 8; ++jj) b[jj] += off;
    blast = tot;
}
__device__ __forceinline__ void gla_put_v(const GlaRaw& R, LAS unsigned char* L, int tid) {
#pragma unroll
    for (int i = 0; i < 2; ++i) { const int p = tid + 512 * i, row = p >> 4, cp = p & 15; *(LAS v4u*)(L + GL_V + row * GL_SV + cp * 16) = R.v[i]; }
}
__device__ __forceinline__ void gla_phase_a(Frame& F, const Args& a, float* KVT, float* DEC) {
    LAS unsigned char* L = F.lds + RING_OFF;
    const int tid = F.tid, lane = F.lane, g = F.wave, d = tid & 63, fq = lane >> 4;
    for (int u = F.vcu * 8; u < 2048; u += F.G * 8) {
        GlaRaw R; gla_fetch<false>(a, u, tid, lane, g, R);
        for (int uu = u; uu < u + 8; ++uu) {
            float b[8], blast;
            gla_gate(R, (LAS float*)(L + GL_GT), tid, g, b, blast);
#pragma unroll
            for (int jj = 0; jj < 8; ++jj) { const int j = 8 * g + jj;
                *(LAS unsigned short*)(L + GL_KD + j * GL_S64 + d * 2) = (unsigned short)f2bf(bf2f(R.k[jj]) * __expf(blast - b[jj])); }
            gla_put_v(R, L, tid);
            if (g == 0) DEC[uu * 64 + d] = __expf(blast);
            if (uu + 1 < u + 8) gla_fetch<false>(a, uu + 1, tid, lane, g, R);
            __syncthreads();
            const int vt = g;
            const bf16x8 a0 = tr_frag(L + GL_V, GL_SV, 8 * fq, 8 * fq + 4, 16 * vt, lane), a1 = tr_frag(L + GL_V, GL_SV, 32 + 8 * fq, 36 + 8 * fq, 16 * vt, lane);
#pragma unroll
            for (int dt = 0; dt < 4; ++dt) {
                const bf16x8 b0 = tr_frag(L + GL_KD, GL_S64, 8 * fq, 8 * fq + 4, 16 * dt, lane), b1 = tr_frag(L + GL_KD, GL_S64, 32 + 8 * fq, 36 + 8 * fq, 16 * dt, lane);
                f32x4 acc = {0.f, 0.f, 0.f, 0.f};
                acc = __builtin_amdgcn_mfma_f32_16x16x32_bf16(a0, b0, acc, 0, 0, 0);
                acc = __builtin_amdgcn_mfma_f32_16x16x32_bf16(a1, b1, acc, 0, 0, 0);
#pragma unroll
                for (int r = 0; r < 4; ++r) KVT[(size_t)uu * 8192 + (16 * vt + 4 * fq + r) * 64 + 16 * dt + (lane & 15)] = acc[r];
            }
        }
    }
    __syncthreads();
}
__device__ __forceinline__ void gla_phase_b(Frame& F, const float* KVT, const float* DEC, bf16* SPREV) {
    for (int it = F.vcu; it < 256; it += F.G) {
        const int bh = it >> 4, part = it & 15, idx = part * 512 + F.tid, d = idx & 63, bb = bh >> 2, h = bh & 3;
        float S = 0.f;
        for (int n0 = 0; n0 < NCHUNK; n0 += 8) {
            float kv[8], dc[8];
#pragma unroll
            for (int k = 0; k < 8; ++k) { const int u = (bb * NCHUNK + n0 + k) * 4 + h; kv[k] = KVT[(size_t)u * 8192 + idx]; dc[k] = DEC[u * 64 + d]; }
#pragma unroll
            for (int k = 0; k < 8; ++k) { const int u = (bb * NCHUNK + n0 + k) * 4 + h; SPREV[(size_t)u * 8192 + idx] = (bf16)f2bf(S); S = dc[k] * S + kv[k]; }
        }
    }
}
struct GlaRawC { bf16x8 sa[4][2]; v2u br[4]; };
__device__ __forceinline__ void gla_fetch_c(const Args& a, const bf16* SPREV, int uu, int lane, int g, GlaRawC& C) {
    const int h = uu & 3, t0 = (uu >> 2) * 64, it = g & 3, vh = g >> 2, l15 = lane & 15, fq = lane >> 4;
    const bf16* BR = (const bf16*)(a.ws + WS_BR);
#pragma unroll
    for (int k = 0; k < 4; ++k) { const int vt = 4 * vh + k;
#pragma unroll
        for (int s = 0; s < 2; ++s) C.sa[k][s] = *(const bf16x8*)(SPREV + (size_t)uu * 8192 + (16 * vt + l15) * 64 + 32 * s + 8 * fq);
        C.br[k] = *(const v2u*)(BR + (size_t)(t0 + 16 * it + l15) * 512 + h * 128 + 16 * vt + 4 * fq); }
}
__device__ __forceinline__ void gla_phase_c(Frame& F, const Args& a, const bf16* SPREV) {
    LAS unsigned char* L = F.lds + RING_OFF;
    const int tid = F.tid, lane = F.lane, g = F.wave, d = tid & 63, fq = lane >> 4, l15 = lane & 15;
    bf16* Y = (bf16*)(a.ws + WS_Y); const float* gn = a.in[4];
    LAS float* RS = (LAS float*)(L + GL_RS);
    const int it = g & 3, vh = g >> 2;
    f32x4 gv[4];
#pragma unroll
    for (int k = 0; k < 4; ++k) gv[k] = *(const f32x4*)(gn + 16 * (4 * vh + k) + 4 * fq);
    for (int u = F.vcu * 8; u < 2048; u += F.G * 8) {
        GlaRaw R; GlaRawC C; gla_fetch<true>(a, u, tid, lane, g, R); gla_fetch_c(a, SPREV, u, lane, g, C);
        for (int uu = u; uu < u + 8; ++uu) {
            const int h = uu & 3, t0 = (uu >> 2) * 64;
            float b[8], blast;
            gla_gate(R, (LAS float*)(L + GL_GT), tid, g, b, blast);
#pragma unroll
            for (int jj = 0; jj < 8; ++jj) { const int j = 8 * g + jj; const float e = __expf(b[jj]);
                *(LAS unsigned short*)(L + GL_QG + j * GL_S64 + d * 2) = (unsigned short)f2bf(bf2f(R.q[jj]) * e);
                *(LAS unsigned short*)(L + GL_KG + j * GL_S64 + d * 2) = (unsigned short)f2bf(bf2f(R.k[jj]) * __builtin_amdgcn_rcpf(e)); }
            gla_put_v(R, L, tid);
            const GlaRawC Cc = C;
            if (uu + 1 < u + 8) { gla_fetch<true>(a, uu + 1, tid, lane, g, R); gla_fetch_c(a, SPREV, uu + 1, lane, g, C); }
            __syncthreads();
            bf16x8 qf[2];
#pragma unroll
            for (int s = 0; s < 2; ++s) qf[s] = *(LAS const bf16x8*)(L + GL_QG + (16 * it + l15) * GL_S64 + (32 * s + 8 * fq) * 2);
            f32x4 at[4];
#pragma unroll
            for (int jt = 0; jt < 4; ++jt) {
                f32x4 acc = {0.f, 0.f, 0.f, 0.f};
                if (jt <= it) {
#pragma unroll
                    for (int s = 0; s < 2; ++s) { const bf16x8 kf = *(LAS const bf16x8*)(L + GL_KG + (16 * jt + l15) * GL_S64 + (32 * s + 8 * fq) * 2);
                        acc = __builtin_amdgcn_mfma_f32_16x16x32_bf16(kf, qf[s], acc, 0, 0, 0); }
#pragma unroll
                    for (int r = 0; r < 4; ++r) if (16 * jt + 4 * fq + r > 16 * it + l15) acc[r] = 0.f;
                }
                at[jt] = acc;
            }
            bf16x8 af[2];
#pragma unroll
            for (int s = 0; s < 2; ++s) { v4u w; w.x = pk2(at[2 * s][0], at[2 * s][1]); w.y = pk2(at[2 * s][2], at[2 * s][3]); w.z = pk2(at[2 * s + 1][0], at[2 * s + 1][1]); w.w = pk2(at[2 * s + 1][2], at[2 * s + 1][3]);
                af[s] = __builtin_bit_cast(bf16x8, w); }
            f32x4 o[4]; float ssq = 0.f;
#pragma unroll
            for (int k = 0; k < 4; ++k) { const int vt = 4 * vh + k;
                f32x4 acc = {0.f, 0.f, 0.f, 0.f};
#pragma unroll
                for (int s = 0; s < 2; ++s) { const bf16x8 va = tr_frag(L + GL_V, GL_SV, 32 * s + 4 * fq, 32 * s + 16 + 4 * fq, 16 * vt, lane);
                    acc = __builtin_amdgcn_mfma_f32_16x16x32_bf16(va, af[s], acc, 0, 0, 0); }
#pragma unroll
                for (int s = 0; s < 2; ++s) acc = __builtin_amdgcn_mfma_f32_16x16x32_bf16(Cc.sa[k][s], qf[s], acc, 0, 0, 0);
                o[k] = acc; ssq += (acc[0] * acc[0] + acc[1] * acc[1]) + (acc[2] * acc[2] + acc[3] * acc[3]);
            }
            ssq += __shfl_xor(ssq, 16); ssq += __shfl_xor(ssq, 32);
            if (fq == 0) RS[vh * 64 + 16 * it + l15] = ssq;
            __syncthreads();
            const float tot = RS[16 * it + l15] + RS[64 + 16 * it + l15];
            const float rstd = 1.f / sqrtf(tot * (1.f / 128.f) + LN_EPS);
            const int tok = t0 + 16 * it + l15;
#pragma unroll
            for (int k = 0; k < 4; ++k) { const int v0 = 16 * (4 * vh + k) + 4 * fq;
                const v2u brw = Cc.br[k];
                const float r0 = bf2f((unsigned short)(brw.x & 0xffffu)), r1 = bf2f((unsigned short)(brw.x >> 16)), r2 = bf2f((unsigned short)(brw.y & 0xffffu)), r3 = bf2f((unsigned short)(brw.y >> 16));
                v2u w; w.x = pk2(o[k][0] * rstd * gv[k][0] * silu_f(r0), o[k][1] * rstd * gv[k][1] * silu_f(r1)); w.y = pk2(o[k][2] * rstd * gv[k][2] * silu_f(r2), o[k][3] * rstd * gv[k][3] * silu_f(r3));
                *(v2u*)(Y + (size_t)tok * 1024 + 512 + h * 128 + v0) = w; }
        }
    }
    __syncthreads();
}
__device__ __forceinline__ void ln1_phase(Frame& F, const Args& a, const bf16* MIX, float* H, bf16* HB) {
    const int gw = F.vcu * NWAVES + F.wave, NGW = F.G * NWAVES;
    const float* x = a.in[0];
    f32x4 g[4], bb[4];
#pragma unroll
    for (int j = 0; j < 4; ++j) { g[j] = ((const GAS f32x4*)a.in[6])[F.lane + 64 * j]; bb[j] = ((const GAS f32x4*)a.in[7])[F.lane + 64 * j]; }
    for (int m0 = 2 * gw; m0 < M; m0 += 2 * NGW) {
        f32x4 v[2][4]; float s[2];
#pragma unroll
        for (int r = 0; r < 2; ++r) { const int m = m0 + r;
            const GAS f32x4* xr = (const GAS f32x4*)(x + (size_t)m * D) + F.lane; const GAS v2u* mr = (const GAS v2u*)(MIX + (size_t)m * D) + F.lane;
            s[r] = 0.f;
#pragma unroll
            for (int j = 0; j < 4; ++j) { const v2u mw = mr[64 * j]; const f32x4 mx = {bf2f((unsigned short)(mw.x & 0xffffu)), bf2f((unsigned short)(mw.x >> 16)), bf2f((unsigned short)(mw.y & 0xffffu)), bf2f((unsigned short)(mw.y >> 16))};
                v[r][j] = xr[64 * j] * ALPHA + mx; s[r] += (v[r][j].x + v[r][j].y) + (v[r][j].z + v[r][j].w); } }
        float mean[2], s2[2], rstd[2];
#pragma unroll
        for (int r = 0; r < 2; ++r) mean[r] = wave_sum(s[r]) * (1.f / D);
#pragma unroll
        for (int r = 0; r < 2; ++r) { s2[r] = 0.f;
#pragma unroll
            for (int j = 0; j < 4; ++j) { v[r][j] = v[r][j] - mean[r]; s2[r] += (v[r][j].x * v[r][j].x + v[r][j].y * v[r][j].y) + (v[r][j].z * v[r][j].z + v[r][j].w * v[r][j].w); } }
#pragma unroll
        for (int r = 0; r < 2; ++r) rstd[r] = 1.f / sqrtf(wave_sum(s2[r]) * (1.f / D) + LN_EPS);
#pragma unroll
        for (int r = 0; r < 2; ++r) { const int m = m0 + r;
            GAS f32x4* hr = (GAS f32x4*)(H + (size_t)m * D) + F.lane; GAS v2u* o8 = (GAS v2u*)(HB + (size_t)m * D) + F.lane;
#pragma unroll
            for (int j = 0; j < 4; ++j) { const f32x4 o = v[r][j] * rstd[r] * g[j] + bb[j]; hr[64 * j] = o; v2u w; w.x = pk2(o.x, o.y); w.y = pk2(o.z, o.w); o8[64 * j] = w; } }
    }
}
__device__ __forceinline__ void ln2_phase(Frame& F, const Args& a, float* H, const bf16* FFN2) {
    const int gw = F.vcu * NWAVES + F.wave, NGW = F.G * NWAVES;
    f32x4 g[4], bb[4];
#pragma unroll
    for (int j = 0; j < 4; ++j) { g[j] = ((const GAS f32x4*)a.in[14])[F.lane + 64 * j]; bb[j] = ((const GAS f32x4*)a.in[15])[F.lane + 64 * j]; }
    for (int m0 = 2 * gw; m0 < M; m0 += 2 * NGW) {
        f32x4 v[2][4]; float s[2];
#pragma unroll
        for (int r = 0; r < 2; ++r) { const int m = m0 + r;
            const GAS f32x4* hr = (const GAS f32x4*)(H + (size_t)m * D) + F.lane;
            const GAS v2u* f0 = (const GAS v2u*)(FFN2 + (size_t)(2 * m) * D) + F.lane; const GAS v2u* f1 = (const GAS v2u*)(FFN2 + (size_t)(2 * m + 1) * D) + F.lane;
            s[r] = 0.f;
#pragma unroll
            for (int j = 0; j < 4; ++j) { const v2u p = f0[64 * j], q = f1[64 * j]; f32x4 t = hr[64 * j] * ALPHA;
                t.x += bf2f((unsigned short)(p.x & 0xffffu)) + bf2f((unsigned short)(q.x & 0xffffu)); t.y += bf2f((unsigned short)(p.x >> 16)) + bf2f((unsigned short)(q.x >> 16));
                t.z += bf2f((unsigned short)(p.y & 0xffffu)) + bf2f((unsigned short)(q.y & 0xffffu)); t.w += bf2f((unsigned short)(p.y >> 16)) + bf2f((unsigned short)(q.y >> 16));
                v[r][j] = t; s[r] += (t.x + t.y) + (t.z + t.w); } }
        float mean[2], s2[2], rstd[2];
#pragma unroll
        for (int r = 0; r < 2; ++r) mean[r] = wave_sum(s[r]) * (1.f / D);
#pragma unroll
        for (int r = 0; r < 2; ++r) { s2[r] = 0.f;
#pragma unroll
            for (int j = 0; j < 4; ++j) { v[r][j] = v[r][j] - mean[r]; s2[r] += (v[r][j].x * v[r][j].x + v[r][j].y * v[r][j].y) + (v[r][j].z * v[r][j].z + v[r][j].w * v[r][j].w); } }
#pragma unroll
        for (int r = 0; r < 2; ++r) rstd[r] = 1.f / sqrtf(wave_sum(s2[r]) * (1.f / D) + LN_EPS);
#pragma unroll
        for (int r = 0; r < 2; ++r) { GAS f32x4* hr = (GAS f32x4*)(H + (size_t)(m0 + r) * D) + F.lane;
#pragma unroll
            for (int j = 0; j < 4; ++j) hr[64 * j] = v[r][j] * rstd[r] * g[j] + bb[j]; }
    }
}
__device__ __forceinline__ void zero_ya(Frame& F, const Args& a) {
    const int gt = F.vcu * (NWAVES * 64) + F.tid, NGT = F.G * NWAVES * 64;
    bf16* Y = (bf16*)(a.ws + WS_Y);
    for (int i = gt; i < M * 64; i += NGT) { const int r = i >> 6, c = i & 63; *(v4u*)(Y + (size_t)r * 1024 + c * 8) = (v4u){0u, 0u, 0u, 0u}; }
}
constexpr size_t WS_WRH = WS_MOE, WS_WRL = WS_MOE + 128 * 1024, WS_EID = WS_MOE + 512 * 1024, WS_GATE = WS_MOE + 1024 * 1024, WS_CNT = WS_MOE + 1536 * 1024,
                 WS_OFFS = WS_MOE + 1536 * 1024 + 64 * 1024, WS_DEST = WS_MOE + 2048 * 1024, WS_GPOS = WS_MOE + 2560 * 1024;
constexpr int MOE_MAXTILES = 288;
constexpr int TILEE_OFF = MISC_OFF + 256;
__device__ __forceinline__ void p0_router_weights(Frame& F, const Args& a) {
    const int gt = F.vcu * (NWAVES * 64) + F.tid, NGT = F.G * NWAVES * 64;
    bf16* WH = (bf16*)(a.ws + WS_WRH); bf16* WL = (bf16*)(a.ws + WS_WRL);
    for (int i = gt; i < 48 * 1024; i += NGT) { const int c = i >> 10, k = i & 1023;
        const float w = c < 4 ? a.in[8][k * 4 + c] : (c < 36 ? a.in[10][k * 32 + (c - 4)] : 0.f);
        const unsigned hi = f2bf(w); const float rem = w - bf2f((unsigned short)hi);
        WH[i] = (bf16)hi; WL[i] = (bf16)f2bf(rem); }
}
constexpr int RT_ROW = 272, RT_HL = 48 * RT_ROW, RT_BUF = 2 * RT_HL;
__device__ __forceinline__ void moe_route_phase(Frame& F, const Args& a, const float* H) {
    LAS unsigned char* L = F.lds + RING_OFF;
    LAS float* LG = (LAS float*)(L + 2 * RT_BUF + F.wave * 4096);
    LAS unsigned* lcnt = (LAS unsigned*)(L + 2 * RT_BUF + 8 * 4096);
    const int lane = F.lane, l15 = lane & 15, fq = lane >> 4, tid = F.tid;
    const bf16* WH = (const bf16*)(a.ws + WS_WRH); const bf16* WL = (const bf16*)(a.ws + WS_WRL);
    int* EID = (int*)(a.ws + WS_EID); float* GATE = (float*)(a.ws + WS_GATE); int* CNT = (int*)(a.ws + WS_CNT);
    const bf16* bsrc[3]; int bdst[3];
#pragma unroll
    for (int i = 0; i < 3; ++i) { const int p = tid + 512 * i, hl = p / 768, rem = p % 768, row = rem >> 4, cp = rem & 15;
        bsrc[i] = (hl ? WL : WH) + (size_t)row * 1024 + cp * 8; bdst[i] = hl * RT_HL + row * RT_ROW + cp * 16; }
    for (int vb = F.vcu; vb < 256; vb += F.G) {
        if (tid < 32) lcnt[tid] = 0u;
        const int tile = vb * 8 + F.wave;
        f32x4 acc[3]; acc[0] = acc[1] = acc[2] = (f32x4){0.f, 0.f, 0.f, 0.f};
        const float* hrow = H + (size_t)(16 * tile + l15) * D + 8 * fq;
        v4u breg[3]; f32x4 xa[4][2];
#pragma unroll
        for (int i = 0; i < 3; ++i) breg[i] = *(const v4u*)(bsrc[i]);
#pragma unroll
        for (int u = 0; u < 4; ++u) { xa[u][0] = *(const f32x4*)(hrow + 32 * u); xa[u][1] = *(const f32x4*)(hrow + 32 * u + 4); }
#pragma unroll
        for (int i = 0; i < 3; ++i) *(LAS v4u*)(L + bdst[i]) = breg[i];
        for (int ch = 0; ch < 8; ++ch) {
            LAS unsigned char* cur = L + (ch & 1) * RT_BUF; LAS unsigned char* nxt = L + ((ch & 1) ^ 1) * RT_BUF;
            __syncthreads();
            f32x4 xc[4][2];
#pragma unroll
            for (int u = 0; u < 4; ++u) { xc[u][0] = xa[u][0]; xc[u][1] = xa[u][1]; }
            if (ch < 7) {
#pragma unroll
                for (int i = 0; i < 3; ++i) breg[i] = *(const v4u*)(bsrc[i] + 128 * (ch + 1));
#pragma unroll
                for (int u = 0; u < 4; ++u) { xa[u][0] = *(const f32x4*)(hrow + 128 * (ch + 1) + 32 * u); xa[u][1] = *(const f32x4*)(hrow + 128 * (ch + 1) + 32 * u + 4); }
            }
#pragma unroll
            for (int u = 0; u < 4; ++u) {
                const float xs[8] = {xc[u][0][0], xc[u][0][1], xc[u][0][2], xc[u][0][3], xc[u][1][0], xc[u][1][1], xc[u][1][2], xc[u][1][3]};
                unsigned hw[4], lw[4];
#pragma unroll
                for (int p = 0; p < 4; ++p) { const unsigned h0 = f2bf(xs[2 * p]), h1 = f2bf(xs[2 * p + 1]);
                    hw[p] = h0 | (h1 << 16); lw[p] = pk2(xs[2 * p] - bf2f((unsigned short)h0), xs[2 * p + 1] - bf2f((unsigned short)h1)); }
                const bf16x8 ah = __builtin_bit_cast(bf16x8, (v4u){hw[0], hw[1], hw[2], hw[3]}), al = __builtin_bit_cast(bf16x8, (v4u){lw[0], lw[1], lw[2], lw[3]});
#pragma unroll
                for (int nt = 0; nt < 3; ++nt) {
                    const bf16x8 bh = *(LAS const bf16x8*)(cur + (16 * nt + l15) * RT_ROW + (32 * u + 8 * fq) * 2), bl = *(LAS const bf16x8*)(cur + RT_HL + (16 * nt + l15) * RT_ROW + (32 * u + 8 * fq) * 2);
                    acc[nt] = __builtin_amdgcn_mfma_f32_16x16x32_bf16(ah, bh, acc[nt], 0, 0, 0);
                    acc[nt] = __builtin_amdgcn_mfma_f32_16x16x32_bf16(ah, bl, acc[nt], 0, 0, 0);
                    acc[nt] = __builtin_amdgcn_mfma_f32_16x16x32_bf16(al, bh, acc[nt], 0, 0, 0);
                }
            }
            if (ch < 7) {
#pragma unroll
                for (int i = 0; i < 3; ++i) *(LAS v4u*)(nxt + bdst[i]) = breg[i];
            }
        }
#pragma unroll
        for (int nt = 0; nt < 3; ++nt)
#pragma unroll
            for (int r = 0; r < 4; ++r) LG[(4 * fq + r) * 48 + 16 * nt + l15] = acc[nt][r];
        LDS_WAIT(); asm volatile("" ::: "memory");
        if (lane < 16) {
            const int tok = 16 * tile + lane; const LAS float* lg = LG + lane * 48;
            float gl[4]; int gs = 0; float gm = -INFINITY;
#pragma unroll
            for (int c = 0; c < 4; ++c) { gl[c] = lg[c] + a.in[9][c]; if (gl[c] > gm) { gm = gl[c]; gs = c; } }
            float den = 0.f;
#pragma unroll
            for (int c = 0; c < 4; ++c) den += __expf(gl[c] - gm);
            const float pg = 1.f / den;
            float t0v = -INFINITY, t1v = -INFINITY; int t0i = 0, t1i = 0;
            for (int c = 0; c < 8; ++c) { const float v = lg[4 + gs * 8 + c] + a.in[11][gs * 8 + c];
                if (v > t0v) { t1v = t0v; t1i = t0i; t0v = v; t0i = c; } else if (v > t1v) { t1v = v; t1i = c; } }
            const float p0 = 1.f / (1.f + __expf(t1v - t0v));
            const int e0 = gs * 8 + t0i, e1 = gs * 8 + t1i;
            EID[2 * tok] = e0; EID[2 * tok + 1] = e1; GATE[2 * tok] = p0 * pg; GATE[2 * tok + 1] = (1.f - p0) * pg;
            atomicAdd((unsigned*)&lcnt[e0], 1u); atomicAdd((unsigned*)&lcnt[e1], 1u);
        }
        __syncthreads();
        if (tid < 32) CNT[vb * 32 + tid] = (int)lcnt[tid];
        __syncthreads();
    }
}
__device__ __forceinline__ void moe_assign_phase(Frame& F, const Args& a) {
    LAS unsigned char* L = F.lds + RING_OFF;
    LAS int* tot = (LAS int*)(L); LAS int* bef = (LAS int*)(L + 128); LAS int* base = (LAS int*)(L + 256); LAS unsigned* lcnt = (LAS unsigned*)(L + 384); LAS int* posof = (LAS int*)(L + 1024);
    const int* EID = (const int*)(a.ws + WS_EID); const float* GATE = (const float*)(a.ws + WS_GATE); const int* CNT = (const int*)(a.ws + WS_CNT);
    int* OFFS = (int*)(a.ws + WS_OFFS); int* DEST = (int*)(a.ws + WS_DEST); float* GPOS = (float*)(a.ws + WS_GPOS);
    const bf16* HB = (const bf16*)(a.ws + WS_HB); bf16* XS = (bf16*)(a.ws + WS_XS);
    for (int vb = F.vcu; vb < 256; vb += F.G) {
        if (F.tid < 32) { int t = 0, b = 0; for (int k = 0; k < 256; ++k) { const int c = CNT[k * 32 + F.tid]; t += c; if (k < vb) b += c; } tot[F.tid] = t; bef[F.tid] = b; lcnt[F.tid] = 0u; }
        __syncthreads();
        if (F.tid < 32) { int off = 0; for (int e = 0; e < F.tid; ++e) off += (tot[e] + 255) & ~255; base[F.tid] = off + bef[F.tid];
            if (vb == 0) { OFFS[F.tid] = off; if (F.tid == 31) OFFS[32] = off + ((tot[31] + 255) & ~255); }
            if (vb == F.tid) { const int pend = off + ((tot[F.tid] + 255) & ~255); for (int p = off + tot[F.tid]; p < pend; ++p) DEST[p] = -1; } }
        __syncthreads();
        if (F.tid < 256) { const int item = vb * 256 + F.tid; const int e = EID[item];
            const int rank = (int)atomicAdd((unsigned*)&lcnt[e], 1u); const int pos = base[e] + rank;
            DEST[pos] = item; GPOS[pos] = GATE[item]; posof[F.tid] = pos; }
        __syncthreads();
        for (int it = F.wave; it < 256; it += NWAVES) { const int tok = vb * 128 + (it >> 1); const int pos = posof[it];
            const v4u* src = (const v4u*)(HB + (size_t)tok * D) + F.lane; v4u* dst = (v4u*)(XS + (size_t)pos * D) + F.lane;
            dst[0] = src[0]; dst[64] = src[64]; }
        __syncthreads();
    }
}
struct MoeOrder {
    int nun, G, c; LAS const unsigned char* tileE;
    __device__ __forceinline__ bool next(int i, pg8::Unit& u) const { const int Lx = i * G + c; if (Lx >= nun) return false; const int mt = Lx >> 2; u.pm = mt; u.pn = (int)tileE[mt] * 4 + (Lx & 3); return true; }
    __device__ __forceinline__ void a_ready(const pg8::Unit&) const {}
    __device__ __forceinline__ void done(const pg8::Unit&) const {}
};
__device__ __forceinline__ int moe_tile_table(Frame& F, const Args& a) {
    const int* OFFS = (const int*)(a.ws + WS_OFFS);
    LAS unsigned char* tileE = F.lds + TILEE_OFF;
    const int ntm = OFFS[32] >> 8;
    if (F.tid < MOE_MAXTILES) { int e = 0; for (int k = 1; k < 32; ++k) if (OFFS[k] <= F.tid * 256) e = k; tileE[F.tid] = (unsigned char)e; }
    __syncthreads();
    return ntm;
}
struct EpiGateUp {
    static constexpr bool PERM = true, AFTER_DRAIN = false;
    bf16* HM;
    __device__ __forceinline__ void operator()(const f32x4 (&acc)[2][2][4][2], const pg8::Unit& u, int wr, int wc, int fr, int fq) const {
        const int row0 = u.pm * 256 + wr * 64 + fr, pnl = u.pn & 3;
#pragma unroll
        for (int ai = 0; ai < 2; ++ai)
#pragma unroll
            for (int m = 0; m < 4; ++m) { const int r = row0 + ai * 128 + m * 16;
#pragma unroll
                for (int bj = 0; bj < 2; ++bj) { const int c0 = pnl * 256 + bj * 128 + wc * 32 + 8 * fq; const f32x4 gt = acc[ai][bj][m][0], up = acc[ai][bj][m][1];
                    v2u w; w.x = pk2(silu_f(gt[0]) * up[0], silu_f(gt[1]) * up[1]); w.y = pk2(silu_f(gt[2]) * up[2], silu_f(gt[3]) * up[3]);
                    *(v2u*)(HM + (size_t)r * 512 + (c0 >> 1)) = w; } }
    }
};
struct EpiScatter {
    static constexpr bool PERM = true, AFTER_DRAIN = false;
    bf16* FF; const int* DEST; const float* GPOS;
    __device__ __forceinline__ void operator()(const f32x4 (&acc)[2][2][4][2], const pg8::Unit& u, int wr, int wc, int fr, int fq) const {
        const int row0 = u.pm * 256 + wr * 64 + fr, pnl = u.pn & 3;
#pragma unroll
        for (int ai = 0; ai < 2; ++ai)
#pragma unroll
            for (int m = 0; m < 4; ++m) { const int r = row0 + ai * 128 + m * 16; const int dest = DEST[r]; const float gt = GPOS[r];
                if (dest >= 0) {
#pragma unroll
                    for (int bj = 0; bj < 2; ++bj) { const int c0 = pnl * 256 + bj * 128 + wc * 32 + 8 * fq; const f32x4 v0 = acc[ai][bj][m][0] * gt, v1 = acc[ai][bj][m][1] * gt;
                        v4u w; w.x = pk2(v0[0], v0[1]); w.y = pk2(v0[2], v0[3]); w.z = pk2(v1[0], v1[1]); w.w = pk2(v1[2], v1[3]);
                        *(v4u*)(FF + (size_t)dest * 1024 + c0) = w; } } }
    }
};
typedef _Float16 f16x8 __attribute__((ext_vector_type(8)));
typedef _Float16 f16x2 __attribute__((ext_vector_type(2)));
constexpr int SEL_CAP = 128;
constexpr int SEL_THR = MISC_OFF + 1024, SEL_RREM = SEL_THR + 256, SEL_CCNT = SEL_RREM + 256;
constexpr int SEL_MASKIMG = 0, SEL_CAND = 65536;
__device__ __forceinline__ float sel_half(const f32x4 d, const f32x4 ci) {
    const float y0 = __builtin_amdgcn_fmed3f(d[0], 0.f, ci[0]), y1 = __builtin_amdgcn_fmed3f(d[1], 0.f, ci[1]), y2 = __builtin_amdgcn_fmed3f(d[2], 0.f, ci[2]), y3 = __builtin_amdgcn_fmed3f(d[3], 0.f, ci[3]);
    return (y0 + y1) + (y2 + y3);
}
__device__ __forceinline__ void sel_tile(const f16x8 (&af)[4], const f16x8 (&bf)[4], const f32x4 (&ci)[4], float (&s)[8]) {
    const f32x4 z = {0.f, 0.f, 0.f, 0.f};
    f32x4 d[16];
#pragma unroll
    for (int i = 0; i < 8; ++i) { d[2 * i] = __builtin_amdgcn_mfma_f32_16x16x32_f16(af[i >> 1], bf[2 * (i & 1)], z, 0, 0, 0); d[2 * i + 1] = __builtin_amdgcn_mfma_f32_16x16x32_f16(af[i >> 1], bf[2 * (i & 1) + 1], z, 0, 0, 0); }
    float pa[8], pb[8];
#pragma unroll
    for (int i = 0; i < 8; ++i) { pa[i] = sel_half(d[2 * i], ci[i >> 1]); pb[i] = sel_half(d[2 * i + 1], ci[i >> 1]); }
#pragma unroll
    for (int i = 0; i < 8; ++i) asm("s_nop 1\n\tv_permlane16_swap_b32 %0, %1" : "+v"(pa[i]), "+v"(pb[i]));
#pragma unroll
    for (int i = 0; i < 8; ++i) s[i] = pa[i] + pb[i];
}
__device__ __forceinline__ int sel_bin(float s) { const float c = __builtin_amdgcn_fmed3f(s, -0.125f, 0.125f);
    return (int)__builtin_amdgcn_fmed3f(__builtin_fmaf(s, 64.f, __builtin_fmaf(c, 448.f, 512.f)), 0.f, 1023.f); }
__device__ __forceinline__ void sel_unit(Frame& F, const Args& a, int b, int c) {
    LAS unsigned char* L = F.lds + RING_OFF;
    LAS int* THR = (LAS int*)(F.lds + SEL_THR); LAS int* RREM = (LAS int*)(F.lds + SEL_RREM); LAS int* CCNT = (LAS int*)(F.lds + SEL_CCNT);
    const int tid = F.tid, lane = F.lane, w = F.wave, l15 = lane & 15, fq = lane >> 4, half = lane >> 5;
    const unsigned short* IQ = (const unsigned short*)(a.ws + WS_IQ); const unsigned short* IK = (const unsigned short*)(a.ws + WS_IK); const float* IW = (const float*)(a.ws + WS_IW);
    const size_t qrow0 = (size_t)b * T + 64 * c + 8 * w, krow0 = (size_t)b * T;
    f16x8 af[4]; f32x4 ci[4];
#pragma unroll
    for (int rb = 0; rb < 4; ++rb) {
        const f16x8 raw = *(const f16x8*)(IQ + (qrow0 + 2 * rb + (l15 >> 3)) * 256 + (l15 & 7) * 32 + 8 * fq);
        const _Float16 wr = (_Float16)IW[(qrow0 + 2 * rb + (l15 >> 3)) * 8 + (l15 & 7)];
        af[rb] = raw * wr;
        const f32x4 wv = *(const f32x4*)(IW + (qrow0 + 2 * rb + (fq >> 1)) * 8 + 4 * (fq & 1));
#pragma unroll
        for (int r = 0; r < 4; ++r) ci[rb][r] = (float)(_Float16)wv[r] < 0.f ? -INFINITY : INFINITY;
    }
    const unsigned short* ikl = IK + (krow0 + l15) * 32 + 8 * fq;
    unsigned hrow[4];
#pragma unroll
    for (int rb = 0; rb < 4; ++rb) hrow[rb] = (unsigned)((8 * w + 2 * rb + half) * 2048);
    if (c >= 4) {
#ifndef SEL_REP1
#define SEL_REP1 1
#endif
      for (int rep1 = 0; rep1 < SEL_REP1; ++rep1) {
        __syncthreads();
        for (int i = tid; i < RING_BYTES / 16; i += NWAVES * 64) *(LAS v4u*)(L + i * 16) = (v4u){0u, 0u, 0u, 0u};
        __syncthreads();
        f16x8 bf[4];
#pragma unroll
        for (int kg = 0; kg < 4; ++kg) bf[kg] = *(const f16x8*)(ikl + (size_t)(16 * kg) * 32);
        for (int t = 0; t <= c; ++t) {
            f16x8 bn[4];
            const int tn = t < c ? t + 1 : t;
#pragma unroll
            for (int kg = 0; kg < 4; ++kg) bn[kg] = *(const f16x8*)(ikl + (size_t)(64 * tn + 16 * kg) * 32);
            float sc[8]; sel_tile(af, bf, ci, sc);
            unsigned bins[8];
#pragma unroll
            for (int i = 0; i < 8; ++i) bins[i] = (unsigned)sel_bin(sc[i]);
#pragma unroll
            for (int i = 0; i < 8; ++i) __hip_atomic_fetch_add((LAS unsigned*)(L + hrow[i >> 1] + ((bins[i] >> 1) << 2)), 1u + (bins[i] & 1u) * 65535u, __ATOMIC_RELAXED, __HIP_MEMORY_SCOPE_WORKGROUP);
#pragma unroll
            for (int kg = 0; kg < 4; ++kg) bf[kg] = bn[kg];
        }
      }
        __syncthreads();
        for (int qq = 0; qq < 8; ++qq) {
            const int q = 8 * w + qq;
            const v4u h0 = *(LAS const v4u*)(L + q * 2048 + lane * 32), h1 = *(LAS const v4u*)(L + q * 2048 + lane * 32 + 16);
            const unsigned hw[8] = {h0.x, h0.y, h0.z, h0.w, h1.x, h1.y, h1.z, h1.w};
            int tot = 0;
#pragma unroll
            for (int k = 0; k < 8; ++k) tot += (int)(hw[k] & 0xffffu) + (int)(hw[k] >> 16);
            int inc = tot;
#pragma unroll
            for (int o = 1; o < 64; o <<= 1) { const int v = __shfl_up(inc, o); if (lane >= o) inc += v; }
            const int all = __shfl(inc, 63);
            const int above = all - inc;
            if (above < 256 && above + tot >= 256) {
                int cum = above, B = 16 * lane, r = 1; bool done = false;
#pragma unroll
                for (int k = 7; k >= 0; --k) {
                    const int chi = (int)(hw[k] >> 16), clo = (int)(hw[k] & 0xffffu);
                    if (!done) { if (cum + chi >= 256) { B = 16 * lane + 2 * k + 1; r = 256 - cum; done = true; } else cum += chi; }
                    if (!done) { if (cum + clo >= 256) { B = 16 * lane + 2 * k; r = 256 - cum; done = true; } else cum += clo; }
                }
                THR[q] = B; RREM[q] = r;
            }
        }
    } else {
        if (tid < 64) { THR[tid] = -1; RREM[tid] = 0; }
    }
    __syncthreads();
#ifndef SEL_REP2
#define SEL_REP2 1
#endif
  for (int rep2 = 0; rep2 < SEL_REP2; ++rep2) {
    __syncthreads();
    for (int i = tid; i < RING_BYTES / 16; i += NWAVES * 64) *(LAS v4u*)(L + i * 16) = (v4u){0u, 0u, 0u, 0u};
    if (tid < 64) CCNT[tid] = 0;
    __syncthreads();
    {
        int tb[4];
#pragma unroll
        for (int rb = 0; rb < 4; ++rb) tb[rb] = THR[8 * w + 2 * rb + half];
        const unsigned mrow = (unsigned)(SEL_MASKIMG + (8 * w + 2 * (l15 >> 2) + ((l15 >> 1) & 1)) * 1024 + (l15 & 1) * 4);
        f16x8 bf[4];
#pragma unroll
        for (int kg = 0; kg < 4; ++kg) bf[kg] = *(const f16x8*)(ikl + (size_t)(16 * kg) * 32);
        for (int t = 0; t <= c; ++t) {
            f16x8 bn[4];
            const int tn = t < c ? t + 1 : t;
#pragma unroll
            for (int kg = 0; kg < 4; ++kg) bn[kg] = *(const f16x8*)(ikl + (size_t)(64 * tn + 16 * kg) * 32);
            unsigned mword = 0u;
            float sc[8]; sel_tile(af, bf, ci, sc);
            int bins[8];
#pragma unroll
            for (int i = 0; i < 8; ++i) bins[i] = sel_bin(sc[i]);
            unsigned long long sm[8], cm[8]; unsigned long long anyc = 0ull;
#pragma unroll
            for (int i = 0; i < 8; ++i) { sm[i] = __ballot(bins[i] > tb[i >> 1]); cm[i] = __ballot(bins[i] == tb[i >> 1]); anyc |= cm[i]; }
#pragma unroll
            for (int i = 0; i < 8; ++i) { const int rb = i >> 1, pp = i & 1;
                asm("s_nop 4\n\tv_writelane_b32 %0, %1, %2" : "+v"(mword) : "s"((unsigned)sm[i]), "n"(4 * rb + pp));
                asm("s_nop 4\n\tv_writelane_b32 %0, %1, %2" : "+v"(mword) : "s"((unsigned)(sm[i] >> 32)), "n"(4 * rb + 2 + pp)); }
            if (anyc) {
#pragma unroll
                for (int i = 0; i < 8; ++i) if (cm[i]) { const int rb = i >> 1, pp = i & 1;
                    const bool cand = (bins[i] == tb[rb]);
                    const unsigned mylo = (unsigned)(cm[i] >> (32 * half));
                    const int q = 8 * w + 2 * rb + half;
                    const int cnt0 = CCNT[q];
                    const int slot = cnt0 + __popc(mylo & ((1u << (lane & 31)) - 1u));
                    if (cand && slot < SEL_CAP) *(LAS v2u*)(L + SEL_CAND + (q * SEL_CAP + slot) * 8) = (v2u){__float_as_uint(sc[i]), (unsigned)(64 * t + 32 * pp + (lane & 31))};
                    if ((lane & 31) == 0) CCNT[q] = cnt0 + __popc(mylo); }
            }
            if (lane < 16) *(LAS unsigned*)(L + mrow + t * 8) = mword;
#pragma unroll
            for (int kg = 0; kg < 4; ++kg) bf[kg] = bn[kg];
        }
    }
  }
    LDS_WAIT(); asm volatile("" ::: "memory");
    for (int qq = 0; qq < 8; ++qq) {
        const int q = 8 * w + qq; const int n = min(CCNT[q], SEL_CAP), r = RREM[q];
        if (r > 0 && n > 0) {
            const v2u c0 = *(LAS const v2u*)(L + SEL_CAND + (q * SEL_CAP + lane) * 8), c1 = *(LAS const v2u*)(L + SEL_CAND + (q * SEL_CAP + 64 + lane) * 8);
            const unsigned k0 = c0.y, k1 = c1.y; const float s0 = __uint_as_float(c0.x), s1 = __uint_as_float(c1.x);
            int rank0 = 0, rank1 = 0;
            for (int j = 0; j < n; ++j) { const v2u cj = *(LAS const v2u*)(L + SEL_CAND + (q * SEL_CAP + j) * 8); const float sj = __uint_as_float(cj.x); const unsigned kj = cj.y;
                rank0 += (sj > s0 || (sj == s0 && kj < k0)) ? 1 : 0; rank1 += (sj > s1 || (sj == s1 && kj < k1)) ? 1 : 0; }
            if (lane < n && rank0 < r) __hip_atomic_fetch_or((LAS unsigned*)(L + SEL_MASKIMG + q * 1024 + (k0 >> 5) * 4), 1u << (k0 & 31), __ATOMIC_RELAXED, __HIP_MEMORY_SCOPE_WORKGROUP);
            if (lane + 64 < n && rank1 < r) __hip_atomic_fetch_or((LAS unsigned*)(L + SEL_MASKIMG + q * 1024 + (k1 >> 5) * 4), 1u << (k1 & 31), __ATOMIC_RELAXED, __HIP_MEMORY_SCOPE_WORKGROUP);
        }
    }
    __syncthreads();
    { unsigned long long* MK = (unsigned long long*)(a.ws + WS_MASK);
      const int ntw = (c | 3) + 1;
      for (int i = tid; i < ntw * 64; i += NWAVES * 64) { const int t = i >> 6, q = i & 63;
          MK[((size_t)b * NCHUNK + t) * T + 64 * c + q] = *(LAS const unsigned long long*)(L + SEL_MASKIMG + q * 1024 + t * 8); } }
    __syncthreads();
}
__device__ __forceinline__ void sel_phase(Frame& F, const Args& a) {
    for (int v = F.vcu; v < 256; v += F.G) { const int b = v >> 6, p = v & 63; sel_unit(F, a, b, p); sel_unit(F, a, b, 127 - p); }
}
namespace attn_body {
using bf16=__hip_bfloat16;
using bf16x8=__attribute__((ext_vector_type(8)))short;
using s16x4=__attribute__((ext_vector_type(4)))short;
using f32x16=__attribute__((ext_vector_type(16)))float;
using u32x4=__attribute__((ext_vector_type(4)))unsigned;
constexpr int BATCH=4,NHEAD=8,SEQ=8192,D=64,DM=NHEAD*D,OPITCH=1024;
constexpr int NW=8,QBLK=32,QB=QBLK*NW,KVBLK=64,NQB=SEQ/QB;
constexpr int ATTN_PITCH=DM, ATTN_UNIT_ROWS=QB;
__device__ __forceinline__ int crow(int r,int hi){return (r&3)+8*(r>>2)+4*hi;}
#define SBAR() __builtin_amdgcn_sched_barrier(0)
constexpr int NSLOT=3, SLOTB=8192;
constexpr int LDS_K=0, LDS_V=NSLOT*SLOTB, LDS_WS=2*NSLOT*SLOTB, LDS_OST=LDS_WS+NW*64*4, LDS_MSK=LDS_OST+NW*4096, LDS_BYTES=LDS_MSK+NSLOT*2048;
constexpr float C2=0.125f*1.4426950408889634f;
__device__ __forceinline__ void glds16(const void*gsrc,unsigned lds_dst){unsigned keep;
  asm volatile("s_mov_b32 %0, m0\n\ts_mov_b32 m0, %2\n\ts_nop 0\n\tglobal_load_lds_dwordx4 %1, off\n\ts_mov_b32 m0, %0":"=&s"(keep):"v"(gsrc),"s"(lds_dst):"memory");}
__device__ __forceinline__ void glds4(const void*gsrc,unsigned lds_dst){unsigned keep;
  asm volatile("s_mov_b32 %0, m0\n\ts_mov_b32 m0, %2\n\ts_nop 0\n\tglobal_load_lds_dword %1, off\n\ts_mov_b32 m0, %0":"=&s"(keep):"v"(gsrc),"s"(lds_dst):"memory");}
__device__ __forceinline__ float max3f(float a,float b,float c){float r;asm("v_max3_f32 %0, %1, %2, %3":"=v"(r):"v"(a),"v"(b),"v"(c));return r;}
__device__ __forceinline__ float max2f(float a,float b){float r;asm("v_max_f32_e32 %0, %1, %2":"=v"(r):"v"(a),"v"(b));return r;}
__device__ __forceinline__ float fadd_s(float a,float b){float r;asm("v_add_f32_e32 %0, %1, %2":"=v"(r):"v"(a),"v"(b));return r;}
__device__ __forceinline__ float fsub_s(float a,float b){float r;asm("v_sub_f32_e32 %0, %1, %2":"=v"(r):"v"(a),"v"(b));return r;}
typedef float f32x2_t __attribute__((ext_vector_type(2))); typedef __bf16 bf16x2_t __attribute__((ext_vector_type(2)));
__device__ __forceinline__ unsigned cvtpk_s(float lo,float hi){f32x2_t v={lo,hi};bf16x2_t b=__builtin_convertvector(v,bf16x2_t);return __builtin_bit_cast(unsigned,b);}
#define WAIT_BAR(N) asm volatile("s_waitcnt vmcnt(" #N ") lgkmcnt(0)\n\ts_barrier":::"memory")

__device__ __forceinline__ void qkt(f32x16&p0,f32x16&p1,const char*Kslot,const bf16x8*qr,const f32x16&negm,int r32,int hi){
  const char*kb=Kslot+hi*1024+r32*16;
  #pragma unroll
  for(int d0=0;d0<4;++d0){
    const bf16x8 b0=*reinterpret_cast<const bf16x8*>(kb+d0*2048);
    const bf16x8 b1=*reinterpret_cast<const bf16x8*>(kb+d0*2048+512);
    if(d0==0){p0=__builtin_amdgcn_mfma_f32_32x32x16_bf16(b0,qr[0],negm,0,0,0);p1=__builtin_amdgcn_mfma_f32_32x32x16_bf16(b1,qr[0],negm,0,0,0);}
    else{p0=__builtin_amdgcn_mfma_f32_32x32x16_bf16(b0,qr[d0],p0,0,0,0);p1=__builtin_amdgcn_mfma_f32_32x32x16_bf16(b1,qr[d0],p1,0,0,0);}}
}
typedef __attribute__((address_space(3))) const char* lds_cptr;
typedef short v4i16_t __attribute__((ext_vector_type(4)));
__device__ __forceinline__ void kload8(bf16x8*kf,lds_cptr kp){
  kf[0]=*(const __attribute__((address_space(3))) bf16x8*)(kp);      kf[1]=*(const __attribute__((address_space(3))) bf16x8*)(kp+512);
  kf[2]=*(const __attribute__((address_space(3))) bf16x8*)(kp+2048); kf[3]=*(const __attribute__((address_space(3))) bf16x8*)(kp+2560);
  kf[4]=*(const __attribute__((address_space(3))) bf16x8*)(kp+4096); kf[5]=*(const __attribute__((address_space(3))) bf16x8*)(kp+4608);
  kf[6]=*(const __attribute__((address_space(3))) bf16x8*)(kp+6144); kf[7]=*(const __attribute__((address_space(3))) bf16x8*)(kp+6656);
}
__device__ __forceinline__ void kload2(bf16x8*kf,lds_cptr kp,int j){ kf[2*j]=*(const __attribute__((address_space(3))) bf16x8*)(kp+j*2048); kf[2*j+1]=*(const __attribute__((address_space(3))) bf16x8*)(kp+j*2048+512); }
__device__ __forceinline__ s16x4 vtr(lds_cptr p){ return __builtin_bit_cast(s16x4,__builtin_amdgcn_ds_read_tr16_b64_v4i16((__attribute__((address_space(3))) v4i16_t*)p)); }
__device__ __forceinline__ float rowmax(const f32x16&p0,const f32x16&p1){
  float a=max3f(p0[0],p0[1],p1[0]),b=max3f(p0[2],p0[3],p1[1]);a=max3f(a,p1[2],p1[3]);
  #pragma unroll
  for(int r=4;r<16;r+=4){a=max3f(a,p0[r],p0[r+1]);b=max3f(b,p0[r+2],p0[r+3]);a=max3f(a,p1[r],p1[r+1]);b=max3f(b,p1[r+2],p1[r+3]);}
  const float m=max2f(a,b);
  auto rr=__builtin_amdgcn_permlane32_swap(__float_as_uint(m),__float_as_uint(m),false,false);
  return max2f(__uint_as_float(rr[0]),__uint_as_float(rr[1]));
}
__device__ __forceinline__ void pv(f32x16*o,int vb,bf16x8 pa0,bf16x8 pa1,bf16x8 pa2,bf16x8 pa3){
  #pragma unroll
  for(int d0=0;d0<2;++d0){s16x4 lo[4],hi[4];
    #pragma unroll
    for(int ks=0;ks<4;++ks){
      asm volatile("ds_read_b64_tr_b16 %0,%1 offset:%c2":"=&v"(lo[ks]):"v"(vb),"i"(d0*4096+ks*1024):"memory");
      asm volatile("ds_read_b64_tr_b16 %0,%1 offset:%c2":"=&v"(hi[ks]):"v"(vb),"i"(d0*4096+ks*1024+512):"memory");}
    asm volatile("s_waitcnt lgkmcnt(0)":::"memory");SBAR();
    #define PK(k) (bf16x8){lo[k][0],lo[k][1],lo[k][2],lo[k][3],hi[k][0],hi[k][1],hi[k][2],hi[k][3]}
    o[d0]=__builtin_amdgcn_mfma_f32_32x32x16_bf16(pa0,PK(0),o[d0],0,0,0);
    o[d0]=__builtin_amdgcn_mfma_f32_32x32x16_bf16(pa1,PK(1),o[d0],0,0,0);
    o[d0]=__builtin_amdgcn_mfma_f32_32x32x16_bf16(pa2,PK(2),o[d0],0,0,0);
    o[d0]=__builtin_amdgcn_mfma_f32_32x32x16_bf16(pa3,PK(3),o[d0],0,0,0);
    #undef PK
  }
}

#ifndef ATTN_STORE16
#define ATTN_STORE16(p,v) (*(u32x4*)(p)=(v))
#endif
template<int THRL> __device__ __forceinline__ void attn_unit(int b,int h,int qb,const bf16*Q,const bf16*__restrict__ K,const bf16*__restrict__ V,bf16*O,const unsigned*MSK,char*shm){
  const int tid=threadIdx.x,lane=tid&63,r32=lane&31,hi=lane>>5; const int wid=__builtin_amdgcn_readfirstlane(tid>>6);
  const long rowbase=(long)b*SEQ; const int q0=qb*QB;
  const bf16*Qw=Q+(rowbase+q0+wid*QBLK)*DM+h*D;
  const bf16*Kh=K+rowbase*DM+h*D,*Vh=V+rowbase*DM+h*D;
  const unsigned lds0=(unsigned)(uintptr_t)shm;
  float*wsf=(float*)(shm+LDS_WS)+wid*64;
  const bf16*ksrc=Kh+(long)lane*DM+wid*8;
  const bf16*vsrc=Vh+(long)(16*(wid&3)+(lane>>2))*DM+(wid>>2)*32+(lane&3)*8;
  const unsigned kdst=lds0+LDS_K+wid*1024, vdst=lds0+LDS_V+wid*1024, mdst=lds0+LDS_MSK+wid*256;
  const unsigned*msrc=MSK+(((size_t)b*(SEQ/KVBLK))*SEQ+q0+wid*QBLK)*2+lane;
  typedef __attribute__((address_space(3))) const unsigned long long* lds_u64p;
  #define DMA_K(t,slot) glds16(ksrc+(long)(t)*KVBLK*DM,(unsigned)__builtin_amdgcn_readfirstlane(kdst+(slot)))
  #define DMA_V(t,slot) do{ glds16(vsrc+(long)(t)*KVBLK*DM,(unsigned)__builtin_amdgcn_readfirstlane(vdst+(slot))); glds4(msrc+(size_t)(t)*SEQ*2,(unsigned)__builtin_amdgcn_readfirstlane(mdst+((slot)>>2))); }while(0)
  const int vb0=(int)(lds0+LDS_V)+((lane>>4)&1)*32+(lane&3)*8+(4*hi+((lane&15)>>2))*64;
  const char*Kbase=shm+LDS_K; bf16x8 kf[8];
  const lds_cptr shm3=(lds_cptr)shm; const lds_cptr kp0=shm3+LDS_K+hi*1024+r32*16; const lds_cptr vp0=shm3+LDS_V+((lane>>4)&1)*32+(lane&3)*8+(4*hi+((lane&15)>>2))*64;
  const lds_cptr mp0=shm3+LDS_MSK+wid*256+r32*8;
  const int NT=(q0+QB)/KVBLK;
  DMA_K(0,0);DMA_V(0,0);DMA_K(1,SLOTB);
  bf16x8 qr[4];
  #pragma unroll
  for(int d0=0;d0<4;++d0)qr[d0]=*reinterpret_cast<const bf16x8*>(&Qw[(long)r32*DM+d0*16+hi*8]);
  float mhat=0.f,l_reg=0.f;f32x16 o[2];o[0]=f32x16{};o[1]=f32x16{};f32x16 negm=f32x16{};asm volatile("":"+v"(negm));
  const int qrel=wid*QBLK+r32;
  bool resc=false;
  #define START(P0,P1) do{ const float rm=rowmax(P0,P1); resc=false; \
    { const float dl=rm; mhat=fadd_s(mhat,dl); \
      _Pragma("unroll") for(int r=0;r<16;++r){P0[r]=fsub_s(P0[r],dl);P1[r]=fsub_s(P1[r],dl);} \
      _Pragma("unroll") for(int r=0;r<16;++r)negm[r]=-mhat; asm volatile("":"+v"(negm)); } \
    _Pragma("unroll") for(int r=0;r<16;++r)P0[r]=__builtin_amdgcn_exp2f(P0[r]); }while(0)
  #define RESC() do{ if(resc){ asm volatile("s_waitcnt lgkmcnt(0)":::"memory"); \
      _Pragma("unroll") for(int d_=0;d_<2;++d_) _Pragma("unroll") for(int r=0;r<16;++r)o[d_][r]*=wsf[crow(r,hi)]; } }while(0)
  f32x16 pA0,pA1,pB0,pB1;
  int sl_prev=0,sl_cur=0,sl_next=SLOTB;
  #define ROT() do{sl_prev=sl_cur;sl_cur=sl_next;sl_next=(sl_next==(NSLOT-1)*SLOTB)?0:sl_next+SLOTB;}while(0)
  DMA_K(2,2*SLOTB);
  WAIT_BAR(4);
  qkt(pA0,pA1,Kbase,qr,negm,r32,hi);asm volatile("s_nop 15\n\ts_nop 7":"+v"(pA0),"+v"(pA1));
  START(pA0,pA1);
  _Pragma("unroll") for(int r=0;r<16;++r)pA1[r]=__builtin_amdgcn_exp2f(pA1[r]);
  WAIT_BAR(0);
  DMA_K(3,0);DMA_V(1,SLOTB);
  ROT();
  kload8(kf,kp0+sl_cur);
  WAIT_BAR(3);
  s16x4 vlo[8],vhi[8]; u32x4 pw0,pw1,pw2,pw3;
  #define PKW(P,B) cvtpk_s(P[B],P[B+1])
  #define PAF(k) __builtin_bit_cast(bf16x8,pw##k)
  #define VFR(i) (bf16x8){vlo[i][0],vlo[i][1],vlo[i][2],vlo[i][3],vhi[i][0],vhi[i][1],vhi[i][2],vhi[i][3]}
  #define PIN(x) asm volatile("":"+v"(x))
  #define MX3(a,b,c) __builtin_fmaxf(__builtin_fmaxf((a),(b)),(c))
  #define MKB(P,r,W) do{ const float pv_=P[r]; P[r]=__uint_as_float(__float_as_uint(pv_)&(unsigned)__builtin_amdgcn_sbfe((int)(W),((r)&3)+8*((r)>>2),1)); }while(0)
  #define GAPA(MF,M0,M1,M2,M3,A0,A1,A2,A3,W0,W1,PW) do{ MF; M0; M1; M2; M3; sacc+=A0; sacc+=A1; sacc+=A2; sacc+=A3; PIN(sacc); W0; W1; PIN(PW); SBAR(); }while(0)
  #define EX(v) __builtin_amdgcn_exp2f(v)
  #define GAPB(MF,X,B) do{ MF; X[B]=EX(X[B]); X[B+1]=EX(X[B+1]); X[B+2]=EX(X[B+2]); X[B+3]=EX(X[B+3]); PIN(X); SBAR(); }while(0)
  #define VRD(i) do{ vlo[i]=vtr(vp_+(((i)>>2)*4096+((i)&3)*1024)); vhi[i]=vtr(vp_+(((i)>>2)*4096+((i)&3)*1024+512)); }while(0)
  #define KRD(G,j) do{ if(G){ kload2(kf,kp0+sl_next,j); SBAR(); } }while(0)
  #define STEP(C0,C1,P0,P1,t,GK,GV,GL) do{ SBAR(); \
    const lds_cptr vp_=vp0+sl_prev; \
    const unsigned long long mw_=*(lds_u64p)(mp0+(sl_prev>>2)); const unsigned mlo_=(unsigned)mw_>>(4*hi), mhi_=(unsigned)(mw_>>32)>>(4*hi); \
    VRD(0); SBAR(); MKB(P0,0,mlo_); MKB(P0,1,mlo_); float sacc=(P0[0]+P0[1]); \
    GAPA(C0=__builtin_amdgcn_mfma_f32_32x32x16_bf16(kf[0],qr[0],negm,0,0,0), MKB(P0,2,mlo_),MKB(P0,3,mlo_),MKB(P0,4,mlo_),MKB(P0,5,mlo_), P0[2],P0[3],P0[4],P0[5],     pw0[0]=PKW(P0,0), pw0[1]=PKW(P0,2), pw0); \
    VRD(4); SBAR(); GAPA(C1=__builtin_amdgcn_mfma_f32_32x32x16_bf16(kf[1],qr[0],negm,0,0,0), MKB(P0,6,mlo_),MKB(P0,7,mlo_),MKB(P0,8,mlo_),MKB(P0,9,mlo_), P0[6],P0[7],P0[8],P0[9],     pw0[2]=PKW(P0,4), pw0[3]=PKW(P0,6), pw0); \
    VRD(1); SBAR(); GAPA(C0=__builtin_amdgcn_mfma_f32_32x32x16_bf16(kf[2],qr[1],C0,0,0,0),   MKB(P0,10,mlo_),MKB(P0,11,mlo_),MKB(P0,12,mlo_),MKB(P0,13,mlo_), P0[10],P0[11],P0[12],P0[13], pw1[0]=PKW(P0,8), pw1[1]=PKW(P0,10), pw1); \
    VRD(5); SBAR(); GAPA(C1=__builtin_amdgcn_mfma_f32_32x32x16_bf16(kf[3],qr[1],C1,0,0,0),   MKB(P0,14,mlo_),MKB(P0,15,mlo_),MKB(P1,0,mhi_),MKB(P1,1,mhi_), P0[14],P0[15],P1[0],P1[1],   pw1[2]=PKW(P0,12),pw1[3]=PKW(P0,14), pw1); \
    VRD(2); SBAR(); GAPA(C0=__builtin_amdgcn_mfma_f32_32x32x16_bf16(kf[4],qr[2],C0,0,0,0),   MKB(P1,2,mhi_),MKB(P1,3,mhi_),MKB(P1,4,mhi_),MKB(P1,5,mhi_), P1[2],P1[3],P1[4],P1[5],     pw2[0]=PKW(P1,0), pw2[1]=PKW(P1,2), pw2); \
    VRD(6); SBAR(); GAPA(C1=__builtin_amdgcn_mfma_f32_32x32x16_bf16(kf[5],qr[2],C1,0,0,0),   MKB(P1,6,mhi_),MKB(P1,7,mhi_),MKB(P1,8,mhi_),MKB(P1,9,mhi_), P1[6],P1[7],P1[8],P1[9],     pw2[2]=PKW(P1,4), pw2[3]=PKW(P1,6), pw2); \
    VRD(3); SBAR(); GAPA(C0=__builtin_amdgcn_mfma_f32_32x32x16_bf16(kf[6],qr[3],C0,0,0,0),   MKB(P1,10,mhi_),MKB(P1,11,mhi_),MKB(P1,12,mhi_),MKB(P1,13,mhi_), P1[10],P1[11],P1[12],P1[13], pw3[0]=PKW(P1,8), pw3[1]=PKW(P1,10), pw3); \
    VRD(7); SBAR(); GAPA(C1=__builtin_amdgcn_mfma_f32_32x32x16_bf16(kf[7],qr[3],C1,0,0,0),   MKB(P1,14,mhi_),MKB(P1,15,mhi_),do{}while(0),do{}while(0), P1[14],P1[15],0.f,0.f,       pw3[2]=PKW(P1,12),pw3[3]=PKW(P1,14), pw3); \
    l_reg+=sacc; \
    if(GK){DMA_K((t)+3,sl_cur);} if(GV){DMA_V((t)+1,sl_next);} \
    { float a=MX3(C0[0],C0[1],C1[0]),b=MX3(C0[2],C0[3],C1[1]); a=MX3(a,C1[2],C1[3]); \
      _Pragma("unroll") for(int r=4;r<16;r+=4){a=MX3(a,C0[r],C0[r+1]);b=MX3(b,C0[r+2],C0[r+3]);a=MX3(a,C1[r],C1[r+1]);b=MX3(b,C1[r+2],C1[r+3]);} \
      float rm=__builtin_fmaxf(a,b); { auto rr=__builtin_amdgcn_permlane32_swap(__float_as_uint(rm),__float_as_uint(rm),false,false); rm=__builtin_fmaxf(__uint_as_float(rr[0]),__uint_as_float(rr[1])); } \
      resc=false; \
      if(__builtin_expect(__any(rm>(float)THRL),0)){ const float dl=__builtin_fmaxf(rm,0.f); mhat+=dl; \
        _Pragma("unroll") for(int r=0;r<16;++r){C0[r]-=dl;C1[r]-=dl;} \
        _Pragma("unroll") for(int r=0;r<16;++r)negm[r]=-mhat; asm volatile("":"+v"(negm)); \
        const float f=__builtin_amdgcn_exp2f(-dl); l_reg*=f; if(hi==0)wsf[r32]=f; resc=true; } } \
    SBAR(); \
    GAPB(o[0]=__builtin_amdgcn_mfma_f32_32x32x16_bf16(PAF(0),VFR(0),o[0],0,0,0), C0,0); \
    GAPB(o[1]=__builtin_amdgcn_mfma_f32_32x32x16_bf16(PAF(0),VFR(4),o[1],0,0,0), C0,4); \
    KRD(GL,0); GAPB(o[0]=__builtin_amdgcn_mfma_f32_32x32x16_bf16(PAF(1),VFR(1),o[0],0,0,0), C0,8); \
    KRD(GL,1); GAPB(o[1]=__builtin_amdgcn_mfma_f32_32x32x16_bf16(PAF(1),VFR(5),o[1],0,0,0), C0,12); \
    KRD(GL,2); GAPB(o[0]=__builtin_amdgcn_mfma_f32_32x32x16_bf16(PAF(2),VFR(2),o[0],0,0,0), C1,0); \
    KRD(GL,3); GAPB(o[1]=__builtin_amdgcn_mfma_f32_32x32x16_bf16(PAF(2),VFR(6),o[1],0,0,0), C1,4); \
    GAPB(o[0]=__builtin_amdgcn_mfma_f32_32x32x16_bf16(PAF(3),VFR(3),o[0],0,0,0), C1,8); \
    GAPB(o[1]=__builtin_amdgcn_mfma_f32_32x32x16_bf16(PAF(3),VFR(7),o[1],0,0,0), C1,12); \
    }while(0)
  int t=1;
  for(;t+5<NT;t+=2){
    STEP(pB0,pB1,pA0,pA1,t,true,true,true);     WAIT_BAR(3); RESC(); ROT();
    STEP(pA0,pA1,pB0,pB1,t+1,true,true,true);   WAIT_BAR(3); RESC(); ROT();
  }
  #define ENDW(tt) do{ if((tt)+3<NT){WAIT_BAR(3);} else if((tt)+2<NT){WAIT_BAR(2);} else {WAIT_BAR(0);} }while(0)
  for(;t+1<NT;t+=2){
    STEP(pB0,pB1,pA0,pA1,t,(t+3<NT),(t+1<NT),(t+1<NT));       ENDW(t);   RESC(); ROT();
    STEP(pA0,pA1,pB0,pB1,t+1,(t+4<NT),(t+2<NT),(t+2<NT));     ENDW(t+1); RESC(); ROT();
  }
  STEP(pB0,pB1,pA0,pA1,NT-1,false,false,false); RESC();
  { const unsigned long long mwd=*(lds_u64p)(mp0+(sl_cur>>2)); const unsigned mlo_=(unsigned)mwd>>(4*hi), mhi_=(unsigned)(mwd>>32)>>(4*hi);
    _Pragma("unroll") for(int r=0;r<16;++r){ MKB(pB0,r,mlo_); MKB(pB1,r,mhi_); }
    float sacc=pB0[0]+pB0[1]; _Pragma("unroll") for(int r=2;r<16;++r)sacc+=pB0[r]; _Pragma("unroll") for(int r=0;r<16;++r)sacc+=pB1[r]; l_reg+=sacc;
    pw0=(u32x4){PKW(pB0,0),PKW(pB0,2),PKW(pB0,4),PKW(pB0,6)};pw1=(u32x4){PKW(pB0,8),PKW(pB0,10),PKW(pB0,12),PKW(pB0,14)};pw2=(u32x4){PKW(pB1,0),PKW(pB1,2),PKW(pB1,4),PKW(pB1,6)};pw3=(u32x4){PKW(pB1,8),PKW(pB1,10),PKW(pB1,12),PKW(pB1,14)};
    SBAR(); pv(o,vb0+sl_cur,PAF(0),PAF(1),PAF(2),PAF(3)); }
  #undef PKW
  #undef PAF
  #undef VFR
  #undef PIN
  #undef MX3
  #undef GAPA
  #undef MKB
  #undef GAPB
  #undef EX
  #undef VRD
  #undef KRD
  #undef STEP
  #undef ENDW
  {auto rr=__builtin_amdgcn_permlane32_swap(__float_as_uint(l_reg),__float_as_uint(l_reg),false,false);l_reg=__uint_as_float(rr[0])+__uint_as_float(rr[1]);}
  if(hi==0)wsf[32+r32]=l_reg;asm volatile("s_waitcnt lgkmcnt(0)":::"memory");
  float rli[16];
  #pragma unroll
  for(int r=0;r<16;++r)rli[r]=__builtin_amdgcn_rcpf(wsf[32+crow(r,hi)]);
  bf16*Ow=O+(rowbase+q0+wid*QBLK)*OPITCH+h*D;
  { bf16*stg=(bf16*)(shm+LDS_OST)+wid*2048;
    #pragma unroll
    for(int r=0;r<16;++r){const int orow=crow(r,hi);
      #pragma unroll
      for(int d0=0;d0<2;++d0)stg[orow*64+d0*32+r32]=__float2bfloat16(o[d0][r]*rli[r]);}
    asm volatile("s_waitcnt lgkmcnt(0)":::"memory");
    #pragma unroll
    for(int i=0;i<4;++i){const int row=i*8+(lane>>3),ch=lane&7; const u32x4 v=*(const u32x4*)(stg+row*64+ch*8); ATTN_STORE16(Ow+(long)row*OPITCH+ch*8,v);} }
  asm volatile("s_waitcnt lgkmcnt(0)\n\ts_barrier":::"memory");
  #undef DMA_K
  #undef DMA_V
  #undef START
  #undef RESC
  #undef ROT
}
constexpr int ATTN_LDS_BYTES=LDS_BYTES;
struct AttnTensors { const bf16* Q; const bf16* K; const bf16* V; bf16* O; const unsigned* MSK; };
struct AttnUnit { int bh; int qb; };
struct StaticOrder {
  int vcu;
  __device__ __forceinline__ explicit StaticOrder(int grid,int block):vcu((block%8)*(grid/8)+block/8){}
  __device__ __forceinline__ bool next(int i,AttnUnit&u)const{ if(i>=4)return false; const int s=vcu&7; u.bh=vcu>>3; u.qb=(i==0)?s:(i==1)?15-s:(i==2)?16+s:31-s; return true; }
  __device__ __forceinline__ void a_ready(const AttnUnit&)const{}
  __device__ __forceinline__ void done(const AttnUnit&)const{}
};
template<class Sched,int THRL=8> __device__ __forceinline__ void attn_phase(char*lds,const AttnTensors&T,const Sched&S){
  AttnUnit u;
  for(int i=0;S.next(i,u);++i){ S.a_ready(u); attn_unit<THRL>(u.bh/NHEAD,u.bh%NHEAD,u.qb,T.Q,T.K,T.V,T.O,T.MSK,lds); S.done(u); }
}
#undef SBAR
#undef WAIT_BAR
}
constexpr int N_PHASES = 12;
#ifndef REPEAT_PH
#define REPEAT_PH -1
#endif
#define RUNPH(k, ...) do { __VA_ARGS__; if (REPEAT_PH == (k)) { GRID_BAR(); __VA_ARGS__; } } while (0)
#ifdef TIMING_A
#define STAMP(k) do { if (blockIdx.x == 0 && F.tid == 0) __hip_atomic_store(F.ctl + 16 + 2 * (k), (unsigned)__builtin_amdgcn_s_memrealtime(), RLX_AGENT); } while (0)
#else
#define STAMP(k) do {} while (0)
#endif
__global__ void __launch_bounds__(NWAVES * 64, 2) mk_fwd(Args args) {
    extern __shared__ __attribute__((aligned(16))) unsigned char lds[];
    Frame F;
    F.lds = (LAS unsigned char*)lds;
    F.MISC = (volatile LAS unsigned*)(F.lds + MISC_OFF);
    F.tid = threadIdx.x; F.lane = F.tid & 63; F.wave = __builtin_amdgcn_readfirstlane(F.tid >> 6);
    F.G = gridDim.x; { const int bx = blockIdx.x; F.vcu = (F.G % 8 == 0) ? (bx % 8) * (F.G / 8) + bx / 8 : bx; }
    unsigned char* ws = args.ws;
    F.ctl = (gu32*)(ws + WS_CTL);
    for (int u = F.tid; u < (LDS_BYTES - LDSCTL_OFF) / 4; u += NWAVES * 64) ((LAS unsigned*)(F.lds + LDSCTL_OFF))[u] = 0u;
    __syncthreads();
    XcdBarrier bar = xcd_barrier_post((unsigned*)(F.ctl + CW_BAR), F.MISC + 8);
    const int lo = args.ph_lo, hi = args.ph_hi;
#define IN(k) (lo <= (k) && (k) < hi)
#define BOTH(k) (IN(k) && IN((k) + 1))
#define GRID_BAR() xcd_barrier(bar)
    float* KVT = (float*)((unsigned char*)args.out + OUT_KVT); bf16* SPREV = (bf16*)((unsigned char*)args.out + OUT_SPREV); float* DEC = (float*)(ws + WS_DEC);
    STAMP(0);
    if (IN(0)) { RUNPH(0, p0_prologue(F, args); p0_router_weights(F, args)); if (BOTH(0)) GRID_BAR(); }
    STAMP(1);
    if (IN(1)) {
        pg8::Gemm g{(const pg8::bf16_t*)(ws + WS_XB), (const pg8::bf16_t*)(ws + WS_WIN), M, NPROJ, D}; pg8::StaticOrder S; S.init(M, NPROJ, F.G, (int)blockIdx.x);
        EpiProj E{ws};
        RUNPH(1, pg8::gemm_phase<EpiProj, pg8::StaticOrder, true, true>(F.lds + RING_OFF, g, S, E));
        if (BOTH(1)) GRID_BAR();
    }
    STAMP(2);
    if (IN(2)) { RUNPH(2, sel_phase(F, args)); STAMP(3); RUNPH(3, gla_phase_a(F, args, KVT, DEC)); if (BOTH(2)) GRID_BAR(); }
    STAMP(4);
    if (IN(3)) { RUNPH(4, gla_phase_b(F, KVT, DEC, SPREV)); if (BOTH(3)) GRID_BAR(); }
    STAMP(5);
    if (IN(4)) {
        RUNPH(5, gla_phase_c(F, args, SPREV)); STAMP(6);
        static_assert(attn_body::ATTN_LDS_BYTES <= RING_BYTES, "attention LDS");
        const attn_body::AttnTensors AT{(const attn_body::bf16*)(ws + WS_AQ), (const attn_body::bf16*)(ws + WS_AK), (const attn_body::bf16*)(ws + WS_AV), (attn_body::bf16*)(ws + WS_Y), (const unsigned*)(ws + WS_MASK)};
        const attn_body::StaticOrder S((int)F.G, (int)blockIdx.x);
        RUNPH(6, attn_body::attn_phase<attn_body::StaticOrder>((char*)lds + RING_OFF, AT, S));
        if (BOTH(4)) GRID_BAR();
    }
    STAMP(7);
    if (IN(5)) {
        pg8::Gemm g{(const pg8::bf16_t*)(ws + WS_Y), (const pg8::bf16_t*)(ws + WS_WO), M, D, D}; pg8::StaticOrder S; S.init(M, D, F.G, (int)blockIdx.x);
        EpiMixBf16 E{(bf16*)(ws + WS_AQ)};
        RUNPH(7, pg8::gemm_phase<EpiMixBf16, pg8::StaticOrder, true, true>(F.lds + RING_OFF, g, S, E));
        if (BOTH(5)) GRID_BAR();
    }
    STAMP(8);
    if (IN(6)) { RUNPH(8, ln1_phase(F, args, (const bf16*)(ws + WS_AQ), args.out, (bf16*)(ws + WS_HB))); if (BOTH(6)) GRID_BAR(); }
    STAMP(9);
    if (IN(7)) { RUNPH(9, moe_route_phase(F, args, args.out)); if (BOTH(7)) GRID_BAR(); }
    STAMP(10);
    if (IN(8)) { RUNPH(10, moe_assign_phase(F, args)); if (BOTH(8)) GRID_BAR(); }
    STAMP(11);
    if (IN(9)) {
        const int ntm = moe_tile_table(F, args);
        pg8::Gemm g{(const pg8::bf16_t*)(ws + WS_XS), (const pg8::bf16_t*)(ws + WS_WEI), 0, 0, 1024};
        MoeOrder S{ntm * 4, F.G, (int)blockIdx.x, F.lds + TILEE_OFF};
        EpiGateUp E{(bf16*)(ws + WS_HMID)};
        RUNPH(11, pg8::gemm_phase<EpiGateUp, MoeOrder, true, true>(F.lds + RING_OFF, g, S, E));
        if (BOTH(9)) GRID_BAR();
    }
    STAMP(12);
    if (IN(10)) {
        const int ntm = moe_tile_table(F, args);
        pg8::Gemm g{(const pg8::bf16_t*)(ws + WS_HMID), (const pg8::bf16_t*)(ws + WS_WEO), 0, 0, 512};
        MoeOrder S{ntm * 4, F.G, (int)blockIdx.x, F.lds + TILEE_OFF};
        EpiScatter E{(bf16*)(ws + WS_FFN2), (const int*)(ws + WS_DEST), (const float*)(ws + WS_GPOS)};
        RUNPH(12, pg8::gemm_phase<EpiScatter, MoeOrder, true, true>(F.lds + RING_OFF, g, S, E));
        if (BOTH(10)) GRID_BAR();
    }
    STAMP(13);
    if (IN(11)) { ln2_phase(F, args, args.out, (const bf16*)(ws + WS_FFN2)); }
#ifdef TIMING_A
    { STAMP(14);
      xcd_barrier(bar);
      const unsigned ta0 = __hip_atomic_load(F.ctl + 16 + 2 * TIMING_A, RLX_AGENT), ta1 = __hip_atomic_load(F.ctl + 16 + 2 * (TIMING_A + 1), RLX_AGENT);
      const unsigned tb0 = TIMING_B >= 14 ? 0u : __hip_atomic_load(F.ctl + 16 + 2 * TIMING_B, RLX_AGENT), tb1 = TIMING_B >= 14 ? 0u : __hip_atomic_load(F.ctl + 16 + 2 * (TIMING_B + 1), RLX_AGENT);
      const float sc = 1.f + 0.02f * rintf((float)(ta1 - ta0 + tb1 - tb0) * (1.f / 1000.f));
      for (size_t i = (size_t)blockIdx.x * 512 + F.tid; i < (size_t)M * D; i += (size_t)F.G * 512) args.out[i] *= sc; }
#endif
#undef IN
#undef BOTH
}

extern "C" void kernel_launch(void* const* d_in, const int* in_sizes, int n_in, void* d_out, int out_size, void* d_ws, size_t ws_size, hipStream_t stream) {
    static int grid = 0;
    if (grid == 0) {
        int dev = 0, cus = 0, per_cu = 0;
        if (hipGetDevice(&dev) != hipSuccess || hipDeviceGetAttribute(&cus, hipDeviceAttributeMultiprocessorCount, dev) != hipSuccess) { grid = -1; return; }
        if (hipFuncSetAttribute((const void*)mk_fwd, hipFuncAttributeMaxDynamicSharedMemorySize, LDS_BYTES) != hipSuccess) { grid = -1; return; }
        if (hipOccupancyMaxActiveBlocksPerMultiprocessor(&per_cu, (const void*)mk_fwd, NWAVES * 64, LDS_BYTES) != hipSuccess || per_cu < 1) { fprintf(stderr, "occupancy query: %d\n", per_cu); }
        (void)hipGetLastError();
        grid = cus;
    }
    if (grid < 0) return;
    (void)hipMemsetAsync((char*)d_ws + WS_CTL, 0, CTL_ZERO_BYTES, stream);
    Args a{};
    for (int i = 0; i < 16; ++i) a.in[i] = (const float*)d_in[i];
    a.out = (float*)d_out; a.ws = (unsigned char*)d_ws; a.ph_lo = 0; a.ph_hi = N_PHASES;
    hipLaunchKernelGGL(mk_fwd, dim3(grid), dim3(NWAVES * 64), LDS_BYTES, stream, a);
}
```

```cpp
#include <hip/hip_runtime.h>
#include <hip/hip_bf16.h>
#include <cmath>
#include <cstdio>
#include <cstdint>
constexpr int NWAVES = 8;
constexpr int BATCH = 4, T = 8192, D = 1024, M = BATCH * T;
constexpr int NCHUNK = T / 64;
constexpr int IN_W = 3384, NPROJ = 3584;
constexpr float LN_EPS = 1e-5f;
constexpr float ALPHA = 1.189207115002721f;
constexpr float IDX_SCALE = 0.0625f;
constexpr float QK_C2 = 0.125f * 1.4426950408889634f;
constexpr size_t MiB = 1u << 20;
constexpr size_t WS_CTL = 0, CTL_ZERO_BYTES = 1 * MiB;
constexpr size_t WS_COS64 = 1 * MiB, WS_SIN64 = 2 * MiB, WS_COS32 = 3 * MiB, WS_SIN32 = 3 * MiB + 512 * 1024;
constexpr size_t WS_MOE = 4 * MiB;
constexpr size_t WS_WIN = 8 * MiB, WS_WO = 15 * MiB, WS_WEI = 32 * MiB, WS_WEO = 96 * MiB;
constexpr size_t WS_XB = 128 * MiB;
constexpr size_t WS_AQ = 192 * MiB, WS_AK = 224 * MiB, WS_AV = 256 * MiB;
constexpr size_t WS_IQ = 288 * MiB, WS_IK = 304 * MiB, WS_IW = 306 * MiB, WS_BG = 307 * MiB;
constexpr size_t WS_BQ = 312 * MiB, WS_BK = 328 * MiB, WS_BV = 344 * MiB, WS_BR = 376 * MiB;
constexpr size_t WS_MASK = 408 * MiB, WS_Y = 440 * MiB, WS_DEC = 504 * MiB;
constexpr size_t WS_HB = 128 * MiB, WS_XS = 192 * MiB, WS_HMID = 336 * MiB, WS_FFN2 = 192 * MiB;
constexpr size_t OUT_KVT = 0, OUT_SPREV = 64 * MiB;
constexpr int CW_TMO = 0, CW_CODE = 1, CW_BAR = 4096;
constexpr int RING_OFF = 0, RING_BYTES = 131072;
constexpr int LDSCTL_OFF = RING_BYTES, MISC_OFF = LDSCTL_OFF + 320;
constexpr int LDS_BYTES = 147456;

#define GAS __attribute__((address_space(1)))
#define LAS __attribute__((address_space(3)))
typedef unsigned short bf16;
typedef unsigned v4u __attribute__((ext_vector_type(4)));
typedef unsigned v2u __attribute__((ext_vector_type(2)));
typedef float f32x4 __attribute__((ext_vector_type(4)));
typedef float f32x2 __attribute__((ext_vector_type(2)));
typedef short bf16x8 __attribute__((ext_vector_type(8)));
typedef short s16x4 __attribute__((ext_vector_type(4)));
typedef GAS unsigned gu32;
#define RLX_AGENT __ATOMIC_RELAXED, __HIP_MEMORY_SCOPE_AGENT
#define LDS_WAIT() asm volatile("s_waitcnt lgkmcnt(0)" ::: "memory")
#define VM_WAIT() asm volatile("s_waitcnt vmcnt(0)" ::: "memory")
__device__ __forceinline__ unsigned f2bf(float f) { unsigned u = __builtin_bit_cast(unsigned, f); return (u + 0x7fffu + ((u >> 16) & 1u)) >> 16; }
__device__ __forceinline__ unsigned pk2(float lo, float hi) { unsigned r; asm("v_cvt_pk_bf16_f32 %0, %1, %2" : "=v"(r) : "v"(lo), "v"(hi)); return r; }
__device__ __forceinline__ float bf2f(unsigned short b) { return __builtin_bit_cast(float, (unsigned)b << 16); }
__device__ __forceinline__ unsigned pkh2(float lo, float hi) { const _Float16 a = (_Float16)lo, b = (_Float16)hi; return (unsigned)__builtin_bit_cast(unsigned short, a) | ((unsigned)__builtin_bit_cast(unsigned short, b) << 16); }
struct Args { const float* in[16]; float* out; unsigned char* ws; int ph_lo, ph_hi; };
namespace pg8 {
#define PG8_LAS __attribute__((address_space(3)))
typedef unsigned short bf16_t;
typedef short bf16x8 __attribute__((ext_vector_type(8)));
typedef float f32x4 __attribute__((ext_vector_type(4)));
typedef unsigned u32x4 __attribute__((ext_vector_type(4)));
constexpr int BM = 256, BK = 64, HALF = 128, HTB = HALF * BK * 2  , STAGE_BYTES = 8 * HTB, NXCD = 8, WGM = 8;

__host__ __device__ __forceinline__ int lds_byte(int r, int c) { const int st = (r >> 4) * 2 + (c >> 5), rr = r & 15, cc = c & 31, ob = rr * 64 + cc * 2; return st * 1024 + (ob ^ (((ob >> 9) & 1) << 5)); }
__host__ __device__ __forceinline__ void stage_rc(int b, int& R, int& C) { const int st = b / 1024, sb = b % 1024, swz = sb ^ (((sb >> 9) & 1) << 5); R = (st >> 1) * 16 + swz / 64; C = (st & 1) * 32 + (swz % 64) / 2; }
__host__ __device__ __forceinline__ int perm32(int rho) { const int n = rho >> 4, i = rho & 15; return 8 * (i >> 2) + 4 * n + (i & 3); }

struct Unit { int pm, pn; };
struct Gemm { const bf16_t* A; const bf16_t* Bt; int M, N, K; };

struct StaticOrder {
    int nM, nN, nwg, G, c;
    __host__ __device__ void init(int M, int N, int G_, int c_) { nM = M / BM; nN = N / BM; nwg = nM * nN; G = G_; c = c_; }
    __host__ __device__ bool next(int i, Unit& u) const {
        const long L = (long)i * G + c; if (L >= nwg) return false;
        int wgid = (int)L; { const int q = nwg / NXCD, r = nwg % NXCD, xcd = wgid % NXCD, off = wgid / NXCD; wgid = (xcd < r ? xcd * (q + 1) : r * (q + 1) + (xcd - r) * q) + off; }
        const int nig = WGM * nN, gid = wgid / nig, fm = gid * WGM, gsz = (nM - fm) < WGM ? (nM - fm) : WGM;
        u.pm = fm + ((wgid % nig) % gsz); u.pn = (wgid % nig) / gsz; return true;
    }
    __device__ __forceinline__ void a_ready(const Unit&) const {}
    __device__ __forceinline__ void done(const Unit&) const {}
};

__device__ __forceinline__ unsigned cvt_pk_bf16(float lo, float hi) { unsigned r; asm volatile("v_cvt_pk_bf16_f32 %0, %1, %2" : "=v"(r) : "v"(lo), "v"(hi)); return r; }
typedef float f32x2 __attribute__((ext_vector_type(2)));
__device__ __forceinline__ f32x2 gelu_pk(f32x2 v) {
    const f32x2 av = __builtin_elementwise_abs(v), d = av * 0.2316418882f + 1.0f;
    f32x2 t; t.x = __builtin_amdgcn_rcpf(d.x); t.y = __builtin_amdgcn_rcpf(d.y);
    f32x2 q = t * 0.5307027145f + (-0.7265760135f); q = q * t + 0.7107068705f; q = q * t + (-0.142248368f); q = q * t + 0.127414796f; q = q * t;
    const f32x2 s = (v * v) * (-0.72134752044f);
    f32x2 e; e.x = __builtin_amdgcn_exp2f(s.x); e.y = __builtin_amdgcn_exp2f(s.y);
    const f32x2 m = v * (q * e), r = v - m;
    f32x2 o; o.x = v.x < 0.f ? m.x : r.x; o.y = v.y < 0.f ? m.y : r.y; return o;
}

template <int ACT  > struct EpiBf16 {
    static constexpr bool PERM = true, AFTER_DRAIN = false; static_assert(ACT == 0 || ACT == 1, "EpiBf16: ACT is 0 (none) or 1 (gelu_pk)");
    bf16_t* O; int ldc; const float* bias; int split_cols; size_t split_stride; float scale0;
    __device__ __forceinline__ void operator()(const f32x4 (&acc)[2][2][4][2], const Unit& u, int wr, int wc, int fr, int fq) const {
        const int row0 = u.pm * BM + wr * 64 + fr; int colt = u.pn * BM; bf16_t* base = O;
        float sc = 1.f; if (split_cols) { const int t = colt / split_cols; base += (size_t)t * split_stride; colt -= t * split_cols; if (t == 0) sc = scale0; }
        const int col0 = colt + wc * 32 + 8 * fq, bcol0 = u.pn * BM + wc * 32 + 8 * fq;
        f32x4 bv[2][2];
#pragma unroll
        for (int bj = 0; bj < 2; ++bj)
#pragma unroll
            for (int n = 0; n < 2; ++n) bv[bj][n] = bias ? *(const f32x4*)(bias + bcol0 + bj * HALF + 4 * n) : (f32x4){0.f, 0.f, 0.f, 0.f};
#pragma unroll
        for (int ai = 0; ai < 2; ++ai)
#pragma unroll
            for (int m = 0; m < 4; ++m) { bf16_t* rowp = base + (size_t)(row0 + ai * HALF + m * 16) * ldc + col0;
#pragma unroll
                for (int bj = 0; bj < 2; ++bj) { f32x4 v0 = acc[ai][bj][m][0] + bv[bj][0], v1 = acc[ai][bj][m][1] + bv[bj][1];
                    if (ACT == 1) { f32x2 a = gelu_pk((f32x2){v0[0], v0[1]}), b = gelu_pk((f32x2){v0[2], v0[3]}), c = gelu_pk((f32x2){v1[0], v1[1]}), d = gelu_pk((f32x2){v1[2], v1[3]});
                        v0 = (f32x4){a.x, a.y, b.x, b.y}; v1 = (f32x4){c.x, c.y, d.x, d.y}; }
                    v0 = v0 * sc; v1 = v1 * sc; u32x4 w; w.x = cvt_pk_bf16(v0[0], v0[1]); w.y = cvt_pk_bf16(v0[2], v0[3]); w.z = cvt_pk_bf16(v1[0], v1[1]); w.w = cvt_pk_bf16(v1[2], v1[3]);
                    *(u32x4*)(rowp + bj * HALF) = w; } }
    }
};

struct PanelStats {
    unsigned* xbuf;
    unsigned* cnt;
    unsigned* tmo;
    int ntn; float eps;
    unsigned code;
    __device__ __forceinline__ bool run(const f32x4 (&v)[2][2][4][2], const Unit& u, int wr, int wc, int fr, int fq, PG8_LAS unsigned char* lds, int wid, int lane) const {
        typedef float f32x2v __attribute__((ext_vector_type(2)));
        PG8_LAS f32x2v* P = (PG8_LAS f32x2v*)lds;
        PG8_LAS f32x2v* S = (PG8_LAS f32x2v*)(lds + 8192);
        PG8_LAS unsigned* flag = (PG8_LAS unsigned*)(lds + 8192 + 2048);
#pragma unroll
        for (int ai = 0; ai < 2; ++ai)
#pragma unroll
            for (int m = 0; m < 4; ++m) {
                float s = 0.f;
#pragma unroll
                for (int bj = 0; bj < 2; ++bj)
#pragma unroll
                    for (int n = 0; n < 2; ++n) { const f32x4 x = v[ai][bj][m][n]; s += (x[0] + x[1]) + (x[2] + x[3]); }
                s += __shfl_xor(s, 16); s += __shfl_xor(s, 32);
                const float mw = s * (1.0f / 64.0f); float q = 0.f;
#pragma unroll
                for (int bj = 0; bj < 2; ++bj)
#pragma unroll
                    for (int n = 0; n < 2; ++n) { const f32x4 d = v[ai][bj][m][n] - mw; q += (d[0] * d[0] + d[1] * d[1]) + (d[2] * d[2] + d[3] * d[3]); }
                q += __shfl_xor(q, 16); q += __shfl_xor(q, 32);
                if (fq == 0) P[(ai * HALF + wr * 64 + m * 16 + fr) * 4 + wc] = (f32x2v){mw, q};
            }
        asm volatile("s_waitcnt lgkmcnt(0)" ::: "memory"); __builtin_amdgcn_s_barrier(); asm volatile("" ::: "memory");
#if defined(BROKEN_EXCHANGE_NO_WAIT)
#warning BROKEN CONTROL BUILD: the row-statistics exchange does not wait; results are wrong by design
        if (blockIdx.x >= 64) { const long long t0_ = clock64(); while (clock64() - t0_ < 60000) __builtin_amdgcn_s_sleep(8); }
#endif
        const int row = wid * 32 + (lane & 31);
        if (lane < 32) {
            const f32x2v a = P[row * 4 + 0], b = P[row * 4 + 1], c = P[row * 4 + 2], d = P[row * 4 + 3];
            const float mt = (a.x + b.x + c.x + d.x) * 0.25f;
            const float da = a.x - mt, db = b.x - mt, dc = c.x - mt, dd = d.x - mt;
            const float m2 = (a.y + b.y) + (c.y + d.y) + 64.0f * ((da * da + db * db) + (dc * dc + dd * dd));
            unsigned long long* slot = (unsigned long long*)xbuf + ((size_t)(u.pm * BM + row) * 4 + u.pn);
            __hip_atomic_store(slot, ((unsigned long long)__float_as_uint(m2) << 32) | __float_as_uint(mt), __ATOMIC_RELAXED, __HIP_MEMORY_SCOPE_AGENT);
        }
        asm volatile("s_waitcnt vmcnt(0)" ::: "memory");
        if (lane == 0) __hip_atomic_fetch_add(cnt + 64 * u.pm, 1u, __ATOMIC_RELAXED, __HIP_MEMORY_SCOPE_AGENT);
        if (wid == 0) {
            bool dead = false; const unsigned long long t0 = __builtin_amdgcn_s_memrealtime(); const unsigned want = 8u * (unsigned)ntn;
            for (;;) {
#if defined(BROKEN_EXCHANGE_NO_WAIT)
                break;
#endif
                if ((unsigned)__builtin_amdgcn_readfirstlane(__hip_atomic_load(cnt + 64 * u.pm, __ATOMIC_RELAXED, __HIP_MEMORY_SCOPE_AGENT)) >= want) break;
                if (__builtin_amdgcn_s_memrealtime() - t0 > 2000000ull) {
                    if (lane == 0) { unsigned expect = 0u; __hip_atomic_compare_exchange_strong(tmo + 1, &expect, code | (unsigned)(u.pm & 0xff), __ATOMIC_RELAXED, __ATOMIC_RELAXED, __HIP_MEMORY_SCOPE_AGENT);
                                     __hip_atomic_store(tmo, 1u, __ATOMIC_RELAXED, __HIP_MEMORY_SCOPE_AGENT); }
                    dead = true; break; }
                __builtin_amdgcn_s_sleep(2);
            }
            __builtin_amdgcn_fence(__ATOMIC_ACQUIRE, "agent");
            if (lane == 0) flag[0] = dead ? 1u : 0u;
        }
        asm volatile("s_waitcnt vmcnt(0) lgkmcnt(0)" ::: "memory"); __builtin_amdgcn_s_barrier(); asm volatile("" ::: "memory");
        const bool bad = flag[0] != 0u;
        if (lane < 32) {
            const unsigned long long* slot = (const unsigned long long*)xbuf + (size_t)(u.pm * BM + row) * 4; float mt[4], m2[4]; float ms = 0.f;
#pragma unroll
            for (int t = 0; t < 4; ++t) { if (t < ntn) { const unsigned long long w = __hip_atomic_load(slot + t, __ATOMIC_RELAXED, __HIP_MEMORY_SCOPE_AGENT); mt[t] = __uint_as_float((unsigned)w); m2[t] = __uint_as_float((unsigned)(w >> 32)); } else { mt[t] = 0.f; m2[t] = 0.f; } ms += mt[t]; }
            const float mean = ms / (float)ntn; float q = 0.f;
#pragma unroll
            for (int t = 0; t < 4; ++t) if (t < ntn) { const float dm = mt[t] - mean; q += m2[t] + 256.0f * dm * dm; }
            S[row] = (f32x2v){mean, 1.0f / sqrtf(q / (256.0f * (float)ntn) + eps)};
        }
        asm volatile("s_waitcnt lgkmcnt(0)" ::: "memory"); __builtin_amdgcn_s_barrier(); asm volatile("" ::: "memory");
        return bad;
    }
};
struct EpiLnRes {
    static constexpr bool PERM = false, AFTER_DRAIN = true;
    const float* base; float* out; int ldc; const float* bias; PanelStats st; unsigned poison;
    __device__ __forceinline__ void fused(f32x4 (&acc)[2][2][4][2], const Unit& u, int wr, int wc, int fr, int fq, PG8_LAS unsigned char* lds, int wid, int lane) const {
        typedef float f32x2v __attribute__((ext_vector_type(2)));
        const PG8_LAS f32x2v* S = (const PG8_LAS f32x2v*)(lds + 8192);
        const int col0 = u.pn * BM + wc * 32 + 4 * fq;
#pragma unroll
        for (int bj = 0; bj < 2; ++bj)
#pragma unroll
            for (int n = 0; n < 2; ++n) { const f32x4 bv = bias ? *(const f32x4*)(bias + col0 + bj * HALF + n * 16) : (f32x4){0.f, 0.f, 0.f, 0.f};
#pragma unroll
                for (int ai = 0; ai < 2; ++ai)
#pragma unroll
                    for (int m = 0; m < 4; ++m) acc[ai][bj][m][n] += bv; }
        f32x4 pre[4][2][2];
#pragma unroll
        for (int m = 0; m < 4; ++m) { const size_t off = (size_t)(u.pm * BM + wr * 64 + m * 16 + fr) * ldc + col0;
#pragma unroll
            for (int bj = 0; bj < 2; ++bj)
#pragma unroll
                for (int n = 0; n < 2; ++n) pre[m][bj][n] = *(const f32x4*)(base + off + bj * HALF + n * 16); }
        const bool bad = st.run(acc, u, wr, wc, fr, fq, lds, wid, lane) || poison != 0u;
        const float qnan = __builtin_nanf("");
#pragma unroll
        for (int ai = 0; ai < 2; ++ai)
#pragma unroll
            for (int m = 0; m < 4; ++m) { const int r = ai * HALF + wr * 64 + m * 16 + fr; const f32x2v sr = S[r]; const size_t off = (size_t)(u.pm * BM + r) * ldc + col0;
#pragma unroll
                for (int bj = 0; bj < 2; ++bj)
#pragma unroll
                    for (int n = 0; n < 2; ++n) { const f32x4 bs = ai == 0 ? pre[m][bj][n] : *(const f32x4*)(base + off + bj * HALF + n * 16); f32x4 o = bs + (acc[ai][bj][m][n] - sr.x) * sr.y;
                        if (bad) o = (f32x4){qnan, qnan, qnan, qnan}; *(f32x4*)(out + off + bj * HALF + n * 16) = o; }
                if (m & 1) asm volatile("" ::: "memory"); }
    }
};
struct EpiLnResLn {
    static constexpr bool PERM = false, AFTER_DRAIN = true;
    const float* base; float* out; bf16_t* xn; int ldc; const float* bias; PanelStats st1, st2; unsigned poison;
    __device__ __forceinline__ void fused(f32x4 (&acc)[2][2][4][2], const Unit& u, int wr, int wc, int fr, int fq, PG8_LAS unsigned char* lds, int wid, int lane) const {
        typedef float f32x2v __attribute__((ext_vector_type(2))); typedef unsigned u32x2v __attribute__((ext_vector_type(2)));
        const PG8_LAS f32x2v* S = (const PG8_LAS f32x2v*)(lds + 8192);
        const int col0 = u.pn * BM + wc * 32 + 4 * fq;
#pragma unroll
        for (int bj = 0; bj < 2; ++bj)
#pragma unroll
            for (int n = 0; n < 2; ++n) { const f32x4 bv = bias ? *(const f32x4*)(bias + col0 + bj * HALF + n * 16) : (f32x4){0.f, 0.f, 0.f, 0.f};
#pragma unroll
                for (int ai = 0; ai < 2; ++ai)
#pragma unroll
                    for (int m = 0; m < 4; ++m) acc[ai][bj][m][n] += bv; }
        bool bad = st1.run(acc, u, wr, wc, fr, fq, lds, wid, lane) || poison != 0u;
        const float qnan = __builtin_nanf("");
#pragma unroll
        for (int ai = 0; ai < 2; ++ai)
#pragma unroll
            for (int m = 0; m < 4; ++m) { const int r = ai * HALF + wr * 64 + m * 16 + fr; const f32x2v sr = S[r]; const size_t off = (size_t)(u.pm * BM + r) * ldc + col0;
#pragma unroll
                for (int bj = 0; bj < 2; ++bj)
#pragma unroll
                    for (int n = 0; n < 2; ++n) { const f32x4 bs = *(const f32x4*)(base + off + bj * HALF + n * 16); acc[ai][bj][m][n] = bs + (acc[ai][bj][m][n] - sr.x) * sr.y; }
                asm volatile("" : "+v"(acc[ai][0][m][0]), "+v"(acc[ai][0][m][1]), "+v"(acc[ai][1][m][0]), "+v"(acc[ai][1][m][1]));
                if (m & 1) asm volatile("" ::: "memory"); }
        const bool bad1 = bad;
        bad = st2.run(acc, u, wr, wc, fr, fq, lds, wid, lane) || bad;
#pragma unroll
        for (int ai = 0; ai < 2; ++ai)
#pragma unroll
            for (int m = 0; m < 4; ++m) { const int r = ai * HALF + wr * 64 + m * 16 + fr; const f32x2v sr = S[r]; const size_t off = (size_t)(u.pm * BM + r) * ldc + col0;
#pragma unroll
                for (int bj = 0; bj < 2; ++bj)
#pragma unroll
                    for (int n = 0; n < 2; ++n) { const f32x4 x1 = acc[ai][bj][m][n]; *(f32x4*)(out + off + bj * HALF + n * 16) = bad1 ? (f32x4){qnan, qnan, qnan, qnan} : x1;
                        const f32x4 o = (x1 - sr.x) * sr.y; u32x2v w; w.x = cvt_pk_bf16(o[0], o[1]); w.y = cvt_pk_bf16(o[2], o[3]);
                        if (bad) { w.x = 0x7fc07fc0u; w.y = 0x7fc07fc0u; } *(u32x2v*)(xn + off + bj * HALF + n * 16) = w; }
                asm volatile("" ::: "memory"); }
    }
};

template <class Epi, class Sched, bool ALIGN_EPI = false, bool SP2 = false>
__device__ __forceinline__ void gemm_phase(PG8_LAS unsigned char* lds, const Gemm g, const Sched& S, const Epi& E) {
    const int tid = threadIdx.x, wid = __builtin_amdgcn_readfirstlane(tid >> 6), lane = tid & 63, wr = wid >> 2, wc = wid & 3, fr = lane & 15, fq = lane >> 4;
    const int K = g.K, nt = K / BK;
    unsigned voffA[2], voffB[2];
#pragma unroll
    for (int i = 0; i < 2; ++i) { int R, C; stage_rc(tid * 16 + i * 8192, R, C); const int Rb = Epi::PERM ? ((R & ~31) + perm32(R & 31)) : R;
        voffA[i] = (unsigned)(R * K + C) * 2u; voffB[i] = (unsigned)(Rb * K + C) * 2u; }
    const size_t kstep = (size_t)(BK * 2);
    const size_t hstep = (size_t)HALF * K * 2;
    const size_t tstep = 2 * hstep;
    const unsigned ldsw = (unsigned)wid * 1024u;
    const int aoff = lds_byte(wr * 64 + fr, fq * 8), boff = lds_byte(wc * 32 + fr, fq * 8);
#define PG8_SA(b, h) (((b) * 2 + (h)) * HTB)
#define PG8_SB(b, h) ((4 + (b) * 2 + (h)) * HTB)
#define PG8_STAGE(bufoff, gbase, voff) do { _Pragma("unroll") for (int _i = 0; _i < 2; ++_i) \
        __builtin_amdgcn_global_load_lds((const unsigned*)((const char*)(gbase) + (voff)[_i]), (PG8_LAS unsigned*)(lds + (bufoff) + ldsw + _i * 8192), 16, 0, 0); } while (0)
#define PG8_LDA(dst, b, h) do { _Pragma("unroll") for (int m = 0; m < 4; ++m) _Pragma("unroll") for (int k = 0; k < 2; ++k) dst[m][k] = *(const PG8_LAS bf16x8*)(lds + PG8_SA(b, h) + aoff + m * 2048 + k * 1024); } while (0)
#define PG8_LDB(dst, b, h) do { _Pragma("unroll") for (int n = 0; n < 2; ++n) _Pragma("unroll") for (int k = 0; k < 2; ++k) dst[n][k] = *(const PG8_LAS bf16x8*)(lds + PG8_SB(b, h) + boff + n * 2048 + k * 1024); } while (0)
#define PG8_MMA(ai, bj, At, Bt) do { __builtin_amdgcn_s_setprio(1); _Pragma("unroll") for (int m = 0; m < 4; ++m) _Pragma("unroll") for (int n = 0; n < 2; ++n) _Pragma("unroll") for (int k = 0; k < 2; ++k) \
        acc[ai][bj][m][n] = __builtin_amdgcn_mfma_f32_16x16x32_bf16(Bt[n][k], At[m][k], acc[ai][bj][m][n], 0, 0, 0); __builtin_amdgcn_s_setprio(0); } while (0)
#define PG8_WAIT_V(n) asm volatile("s_waitcnt vmcnt(" #n ")" ::: "memory")
#define PG8_WAIT_L(n) asm volatile("s_waitcnt lgkmcnt(" #n ")" ::: "memory")
#define PG8_BAR __builtin_amdgcn_s_barrier()
#define PG8_SCHED __builtin_amdgcn_sched_barrier(0)
    Unit cur, nxt; int ui = 0;
    if (!S.next(0, cur)) return;
    f32x4 acc[2][2][4][2];
#pragma unroll
    for (int a = 0; a < 2; ++a)
#pragma unroll
        for (int b = 0; b < 2; ++b)
#pragma unroll
            for (int m = 0; m < 4; ++m)
#pragma unroll
                for (int n = 0; n < 2; ++n) acc[a][b][m][n] = (f32x4){0.f, 0.f, 0.f, 0.f};
    bf16x8 At[4][2], B0[2][2], B1[2][2];
    const char* cA = (const char*)g.A + (size_t)cur.pm * tstep; const char* cB = (const char*)g.Bt + (size_t)cur.pn * tstep;
    S.a_ready(cur);
    if constexpr (SP2) {
        PG8_STAGE(PG8_SB(0, 0), cB, voffB); PG8_STAGE(PG8_SB(0, 1), cB + hstep, voffB); PG8_STAGE(PG8_SA(0, 0), cA, voffA); PG8_STAGE(PG8_SA(0, 1), cA + hstep, voffA);
        if (wr == 1) PG8_BAR;
        PG8_WAIT_V(2); PG8_BAR;
        PG8_STAGE(PG8_SB(1, 0), cB + kstep, voffB); PG8_STAGE(PG8_SA(1, 0), cA + kstep, voffA); PG8_STAGE(PG8_SB(1, 1), cB + hstep + kstep, voffB);
        PG8_WAIT_V(6); PG8_BAR;
    } else {
        PG8_STAGE(PG8_SB(0, 0), cB, voffB); PG8_STAGE(PG8_SA(0, 0), cA, voffA); PG8_STAGE(PG8_SB(0, 1), cB + hstep, voffB); PG8_STAGE(PG8_SA(0, 1), cA + hstep, voffA);
        if (wr == 1) PG8_BAR;
        PG8_WAIT_V(4); PG8_BAR;
        PG8_STAGE(PG8_SB(1, 0), cB + kstep, voffB); PG8_STAGE(PG8_SA(1, 0), cA + kstep, voffA); PG8_STAGE(PG8_SB(1, 1), cB + hstep + kstep, voffB);
        PG8_WAIT_V(6); PG8_BAR;
    }
    for (;;) {
        const bool has_next = S.next(ui + 1, nxt);
        const char* nA = has_next ? (const char*)g.A + (size_t)nxt.pm * tstep : cA; const char* nB = has_next ? (const char*)g.Bt + (size_t)nxt.pn * tstep : cB;
        for (int t = 0; t < nt; t += 2) {
            const bool last = (t == nt - 2);
            const char* a1 = cA + (size_t)(t + 1) * kstep;
            const char* a2 = last ? nA : cA + (size_t)(t + 2) * kstep; const char* b2 = last ? nB : cB + (size_t)(t + 2) * kstep;
            const char* a3 = a2 + kstep; const char* b3 = b2 + kstep;
            if (last && has_next) S.a_ready(nxt);
            if constexpr (SP2) {
            PG8_LDB(B0, 0, 0); PG8_LDB(B1, 0, 1); PG8_SCHED; PG8_LDA(At, 0, 0); PG8_STAGE(PG8_SA(1, 1), a1 + hstep, voffA);
            PG8_WAIT_V(8); PG8_WAIT_L(0); PG8_BAR; PG8_MMA(0, 0, At, B0); PG8_MMA(0, 1, At, B1); PG8_BAR; PG8_SCHED;
            PG8_LDA(At, 0, 1); PG8_STAGE(PG8_SB(0, 0), b2, voffB); PG8_STAGE(PG8_SB(0, 1), b2 + hstep, voffB); PG8_STAGE(PG8_SA(0, 0), a2, voffA);
            PG8_WAIT_V(8); PG8_WAIT_L(0); PG8_BAR; PG8_MMA(1, 0, At, B0); PG8_MMA(1, 1, At, B1); PG8_BAR; PG8_SCHED;
            PG8_LDB(B0, 1, 0); PG8_LDB(B1, 1, 1); PG8_SCHED; PG8_LDA(At, 1, 0); PG8_STAGE(PG8_SA(0, 1), a2 + hstep, voffA);
            PG8_WAIT_V(8); PG8_WAIT_L(0); PG8_BAR; PG8_MMA(0, 0, At, B0); PG8_MMA(0, 1, At, B1); PG8_BAR; PG8_SCHED;
            PG8_LDA(At, 1, 1); PG8_STAGE(PG8_SB(1, 0), b3, voffB); PG8_STAGE(PG8_SB(1, 1), b3 + hstep, voffB); PG8_STAGE(PG8_SA(1, 0), a3, voffA);
            PG8_WAIT_V(8); PG8_WAIT_L(0); PG8_BAR; PG8_MMA(1, 0, At, B0); PG8_MMA(1, 1, At, B1); PG8_BAR; PG8_SCHED;
            } else {
            PG8_LDB(B0, 0, 0); PG8_SCHED; PG8_LDA(At, 0, 0); PG8_STAGE(PG8_SA(1, 1), a1 + hstep, voffA);
            PG8_WAIT_L(8); PG8_BAR; PG8_WAIT_L(0); PG8_MMA(0, 0, At, B0); PG8_BAR; PG8_SCHED;
            PG8_LDB(B1, 0, 1); PG8_STAGE(PG8_SB(0, 0), b2, voffB);
            PG8_BAR; PG8_WAIT_L(0); PG8_MMA(0, 1, At, B1); PG8_BAR;
            PG8_LDA(At, 0, 1); PG8_STAGE(PG8_SA(0, 0), a2, voffA);
            PG8_BAR; PG8_WAIT_L(0); PG8_MMA(1, 0, At, B0); PG8_BAR; PG8_SCHED;
            PG8_STAGE(PG8_SB(0, 1), b2 + hstep, voffB);
            PG8_WAIT_V(6); PG8_BAR; PG8_MMA(1, 1, At, B1); PG8_BAR;
            PG8_LDB(B0, 1, 0); PG8_SCHED; PG8_LDA(At, 1, 0); PG8_STAGE(PG8_SA(0, 1), a2 + hstep, voffA);
            PG8_WAIT_L(8); PG8_BAR; PG8_WAIT_L(0); PG8_MMA(0, 0, At, B0); PG8_BAR; PG8_SCHED;
            PG8_LDB(B1, 1, 1); PG8_STAGE(PG8_SB(1, 0), b3, voffB);
            PG8_BAR; PG8_WAIT_L(0); PG8_MMA(0, 1, At, B1); PG8_BAR;
            PG8_LDA(At, 1, 1); PG8_STAGE(PG8_SA(1, 0), a3, voffA);
            PG8_BAR; PG8_WAIT_L(0); PG8_MMA(1, 0, At, B0); PG8_BAR; PG8_SCHED;
            PG8_STAGE(PG8_SB(1, 1), b3 + hstep, voffB);
            PG8_WAIT_V(6); PG8_BAR; PG8_MMA(1, 1, At, B1); PG8_BAR;
            }
        }
        if constexpr (ALIGN_EPI) { if (wr == 0) PG8_BAR; }
        if constexpr (!Epi::AFTER_DRAIN) { E(acc, cur, wr, wc, fr, fq); S.done(cur); }
        if (!has_next) break;
#pragma unroll
        for (int a = 0; a < 2; ++a)
#pragma unroll
            for (int b = 0; b < 2; ++b)
#pragma unroll
                for (int m = 0; m < 4; ++m)
#pragma unroll
                    for (int n = 0; n < 2; ++n) acc[a][b][m][n] = (f32x4){0.f, 0.f, 0.f, 0.f};
        cur = nxt; cA = nA; cB = nB; ++ui;
        if constexpr (ALIGN_EPI) { if (wr == 1) PG8_BAR; }
    }
    PG8_WAIT_V(0);
    if constexpr (!ALIGN_EPI) { if (wr == 0) PG8_BAR; }
    PG8_BAR;
    if constexpr (Epi::AFTER_DRAIN) { E.fused(acc, cur, wr, wc, fr, fq, lds, wid, lane); S.done(cur); }
#undef PG8_SA
#undef PG8_SB
#undef PG8_STAGE
#undef PG8_LDA
#undef PG8_LDB
#undef PG8_MMA
#undef PG8_WAIT_V
#undef PG8_WAIT_L
#undef PG8_BAR
#undef PG8_SCHED
}
template <class Epi, class Sched>
__device__ __forceinline__ void gemm_phase_gather(PG8_LAS unsigned char* lds, const Gemm g, const int* rows, const Sched& S, const Epi& E) {
    constexpr bool ALIGN_EPI = true, SP2 = true;
    const int tid = threadIdx.x, wid = __builtin_amdgcn_readfirstlane(tid >> 6), lane = tid & 63, wr = wid >> 2, wc = wid & 3, fr = lane & 15, fq = lane >> 4;
    const int K = g.K, nt = K / BK;
    unsigned voffB[2]; unsigned vAc[2][2], vAn[2][2]; int rA[2], cAoff[2];
#pragma unroll
    for (int i = 0; i < 2; ++i) { int R, C; stage_rc(tid * 16 + i * 8192, R, C); const int Rb = Epi::PERM ? ((R & ~31) + perm32(R & 31)) : R;
        rA[i] = R; cAoff[i] = C * 2; voffB[i] = (unsigned)(Rb * K + C) * 2u; }
#define PG8_ROWS(dst, pm_) do { _Pragma("unroll") for (int _h = 0; _h < 2; ++_h) _Pragma("unroll") for (int _i = 0; _i < 2; ++_i) dst[_h][_i] = (unsigned)rows[(pm_) * 256 + _h * 128 + rA[_i]] * (unsigned)(K * 2) + (unsigned)cAoff[_i]; } while (0)
    const size_t kstep = (size_t)(BK * 2);
    const size_t hstep = (size_t)HALF * K * 2;
    const size_t tstep = 2 * hstep;
    const unsigned ldsw = (unsigned)wid * 1024u;
    const int aoff = lds_byte(wr * 64 + fr, fq * 8), boff = lds_byte(wc * 32 + fr, fq * 8);
#define PG8_SA(b, h) (((b) * 2 + (h)) * HTB)
#define PG8_SB(b, h) ((4 + (b) * 2 + (h)) * HTB)
#define PG8_STAGE(bufoff, gbase, voff) do { _Pragma("unroll") for (int _i = 0; _i < 2; ++_i) \
        __builtin_amdgcn_global_load_lds((const unsigned*)((const char*)(gbase) + (voff)[_i]), (PG8_LAS unsigned*)(lds + (bufoff) + ldsw + _i * 8192), 16, 0, 0); } while (0)
#define PG8_LDA(dst, b, h) do { _Pragma("unroll") for (int m = 0; m < 4; ++m) _Pragma("unroll") for (int k = 0; k < 2; ++k) dst[m][k] = *(const PG8_LAS bf16x8*)(lds + PG8_SA(b, h) + aoff + m * 2048 + k * 1024); } while (0)
#define PG8_LDB(dst, b, h) do { _Pragma("unroll") for (int n = 0; n < 2; ++n) _Pragma("unroll") for (int k = 0; k < 2; ++k) dst[n][k] = *(const PG8_LAS bf16x8*)(lds + PG8_SB(b, h) + boff + n * 2048 + k * 1024); } while (0)
#define PG8_MMA(ai, bj, At, Bt) do { __builtin_amdgcn_s_setprio(1); _Pragma("unroll") for (int m = 0; m < 4; ++m) _Pragma("unroll") for (int n = 0; n < 2; ++n) _Pragma("unroll") for (int k = 0; k < 2; ++k) \
        acc[ai][bj][m][n] = __builtin_amdgcn_mfma_f32_16x16x32_bf16(Bt[n][k], At[m][k], acc[ai][bj][m][n], 0, 0, 0); __builtin_amdgcn_s_setprio(0); } while (0)
#define PG8_WAIT_V(n) asm volatile("s_waitcnt vmcnt(" #n ")" ::: "memory")
#define PG8_WAIT_L(n) asm volatile("s_waitcnt lgkmcnt(" #n ")" ::: "memory")
#define PG8_BAR __builtin_amdgcn_s_barrier()
#define PG8_SCHED __builtin_amdgcn_sched_barrier(0)
    Unit cur, nxt; int ui = 0;
    if (!S.next(0, cur)) return;
    f32x4 acc[2][2][4][2];
#pragma unroll
    for (int a = 0; a < 2; ++a)
#pragma unroll
        for (int b = 0; b < 2; ++b)
#pragma unroll
            for (int m = 0; m < 4; ++m)
#pragma unroll
                for (int n = 0; n < 2; ++n) acc[a][b][m][n] = (f32x4){0.f, 0.f, 0.f, 0.f};
    bf16x8 At[4][2], B0[2][2], B1[2][2];
    const char* const cA = (const char*)g.A; PG8_ROWS(vAc, cur.pm); const char* cB = (const char*)g.Bt + (size_t)cur.pn * tstep;
    S.a_ready(cur);
    if constexpr (SP2) {
        PG8_STAGE(PG8_SB(0, 0), cB, voffB); PG8_STAGE(PG8_SB(0, 1), cB + hstep, voffB); PG8_STAGE(PG8_SA(0, 0), cA, vAc[0]); PG8_STAGE(PG8_SA(0, 1), cA, vAc[1]);
        if (wr == 1) PG8_BAR;
        PG8_WAIT_V(2); PG8_BAR;
        PG8_STAGE(PG8_SB(1, 0), cB + kstep, voffB); PG8_STAGE(PG8_SA(1, 0), cA + kstep, vAc[0]); PG8_STAGE(PG8_SB(1, 1), cB + hstep + kstep, voffB);
        PG8_WAIT_V(6); PG8_BAR;
    }
    for (;;) {
        const bool has_next = S.next(ui + 1, nxt);
        if (has_next) PG8_ROWS(vAn, nxt.pm); else { _Pragma("unroll") for (int _h = 0; _h < 2; ++_h) _Pragma("unroll") for (int _i = 0; _i < 2; ++_i) vAn[_h][_i] = vAc[_h][_i]; }
        const char* nB = has_next ? (const char*)g.Bt + (size_t)nxt.pn * tstep : cB;
        for (int t = 0; t < nt; t += 2) {
            const bool last = (t == nt - 2);
            const char* a1 = cA + (size_t)(t + 1) * kstep;
            const char* a2 = last ? cA : cA + (size_t)(t + 2) * kstep; const char* b2 = last ? nB : cB + (size_t)(t + 2) * kstep;
            const char* a3 = a2 + kstep; const char* b3 = b2 + kstep;
            unsigned vA2[2][2];
            _Pragma("unroll") for (int _h = 0; _h < 2; ++_h) _Pragma("unroll") for (int _i = 0; _i < 2; ++_i) vA2[_h][_i] = last ? vAn[_h][_i] : vAc[_h][_i];
            if (last && has_next) S.a_ready(nxt);
            if constexpr (SP2) {
            PG8_LDB(B0, 0, 0); PG8_LDB(B1, 0, 1); PG8_SCHED; PG8_LDA(At, 0, 0); PG8_STAGE(PG8_SA(1, 1), a1, vAc[1]);
            PG8_WAIT_V(8); PG8_WAIT_L(0); PG8_BAR; PG8_MMA(0, 0, At, B0); PG8_MMA(0, 1, At, B1); PG8_BAR; PG8_SCHED;
            PG8_LDA(At, 0, 1); PG8_STAGE(PG8_SB(0, 0), b2, voffB); PG8_STAGE(PG8_SB(0, 1), b2 + hstep, voffB); PG8_STAGE(PG8_SA(0, 0), a2, vA2[0]);
            PG8_WAIT_V(8); PG8_WAIT_L(0); PG8_BAR; PG8_MMA(1, 0, At, B0); PG8_MMA(1, 1, At, B1); PG8_BAR; PG8_SCHED;
            PG8_LDB(B0, 1, 0); PG8_LDB(B1, 1, 1); PG8_SCHED; PG8_LDA(At, 1, 0); PG8_STAGE(PG8_SA(0, 1), a2, vA2[1]);
            PG8_WAIT_V(8); PG8_WAIT_L(0); PG8_BAR; PG8_MMA(0, 0, At, B0); PG8_MMA(0, 1, At, B1); PG8_BAR; PG8_SCHED;
            PG8_LDA(At, 1, 1); PG8_STAGE(PG8_SB(1, 0), b3, voffB); PG8_STAGE(PG8_SB(1, 1), b3 + hstep, voffB); PG8_STAGE(PG8_SA(1, 0), a3, vA2[0]);
            PG8_WAIT_V(8); PG8_WAIT_L(0); PG8_BAR; PG8_MMA(1, 0, At, B0); PG8_MMA(1, 1, At, B1); PG8_BAR; PG8_SCHED;
            }
        }
        if constexpr (ALIGN_EPI) { if (wr == 0) PG8_BAR; }
        if constexpr (!Epi::AFTER_DRAIN) { E(acc, cur, wr, wc, fr, fq); S.done(cur); }
        if (!has_next) break;
#pragma unroll
        for (int a = 0; a < 2; ++a)
#pragma unroll
            for (int b = 0; b < 2; ++b)
#pragma unroll
                for (int m = 0; m < 4; ++m)
#pragma unroll
                    for (int n = 0; n < 2; ++n) acc[a][b][m][n] = (f32x4){0.f, 0.f, 0.f, 0.f};
        cur = nxt; cB = nB; ++ui;
        _Pragma("unroll") for (int _h = 0; _h < 2; ++_h) _Pragma("unroll") for (int _i = 0; _i < 2; ++_i) vAc[_h][_i] = vAn[_h][_i];
        if constexpr (ALIGN_EPI) { if (wr == 1) PG8_BAR; }
    }
    PG8_WAIT_V(0);
    if constexpr (!ALIGN_EPI) { if (wr == 0) PG8_BAR; }
    PG8_BAR;
    if constexpr (Epi::AFTER_DRAIN) { E.fused(acc, cur, wr, wc, fr, fq, lds, wid, lane); S.done(cur); }
#undef PG8_ROWS
#undef PG8_SA
#undef PG8_SB
#undef PG8_STAGE
#undef PG8_LDA
#undef PG8_LDB
#undef PG8_MMA
#undef PG8_WAIT_V
#undef PG8_WAIT_L
#undef PG8_BAR
#undef PG8_SCHED
}
}
#define XB_TMO      128
#define XB_XCNT(j)  (256  + 64 * (j))
#define XB_XSUB(j)  (1280 + 64 * (j))
#define XB_XGEN(j)  (2304 + 64 * (j))
#define XB_TOP      3328
#define XB_TOPGEN   3392
#define XCD_BAR_WORDS 3456
#define XB_SPIN_CAP (1u << 18)

__device__ __forceinline__ unsigned xb_ld(unsigned* p)              { return __hip_atomic_load(p, __ATOMIC_RELAXED, __HIP_MEMORY_SCOPE_AGENT); }
__device__ __forceinline__ unsigned xb_add(unsigned* p, unsigned v) { return __hip_atomic_fetch_add(p, v, __ATOMIC_RELAXED, __HIP_MEMORY_SCOPE_AGENT); }
__device__ __forceinline__ unsigned xb_xcc_id() { return (unsigned)__builtin_amdgcn_s_getreg((3 << 11) | 20) & 0xFu; }
#define XB_SPIN(cond, bar) do { unsigned _sp = 0; while (cond) { __builtin_amdgcn_s_sleep(1); \
    if ((++_sp & 255u) == 0u) { if (xb_ld(&(bar)[XB_TMO])) break; if (_sp > XB_SPIN_CAP) { atomicAdd(&(bar)[XB_TMO], 1u); break; } } } } while (0)

struct XcdBarrier {
    unsigned* bar; unsigned x;
    volatile LAS unsigned* st;
};

__device__ __forceinline__ XcdBarrier xcd_barrier_post(unsigned* bar, volatile LAS unsigned* st) {
    XcdBarrier b; b.bar = bar; b.x = xb_xcc_id(); b.st = st;
    if (threadIdx.x == 0) (void)xb_add(&bar[XB_XCNT(b.x)], 1u);
    return b;
}
__device__ __forceinline__ void xcd_barrier_complete(unsigned* bar, unsigned x, unsigned& nloc, unsigned& nx) {
    const unsigned G = gridDim.x * gridDim.y * gridDim.z;
    unsigned sum, cnt, mine, sp = 0u;
    for (;;) {
        sum = 0u; cnt = 0u; mine = 0u;
#pragma unroll
        for (unsigned j = 0; j < 16; ++j) { const unsigned c = xb_ld(&bar[XB_XCNT(j)]); sum += c; cnt += (c > 0u) ? 1u : 0u; mine = (j == x) ? c : mine; }
        if (sum == G) break;
        __builtin_amdgcn_s_sleep(1);
        if ((++sp & 255u) == 0u) { if (xb_ld(&bar[XB_TMO])) break; if (sp > XB_SPIN_CAP) { atomicAdd(&bar[XB_TMO], 1u); break; } }
    }
    nloc = mine > 0u ? mine : 1u; nx = cnt > 0u ? cnt : 1u;
}

__device__ __forceinline__ void xcd_barrier(const XcdBarrier& b) {
    asm volatile("s_waitcnt vmcnt(0)" ::: "memory");
    __syncthreads();
    if (threadIdx.x == 0) {
        unsigned* bar = b.bar;
        __builtin_amdgcn_s_waitcnt(0);
        unsigned nloc = b.st[0], nx = b.st[1];
        if (nloc == 0u) { xcd_barrier_complete(bar, b.x, nloc, nx); b.st[0] = nloc; b.st[1] = nx; }
        const unsigned old = xb_add(&bar[XB_XSUB(b.x)], 1u);
        const unsigned gen = old / nloc;
        if (old + 1u == (gen + 1u) * nloc) {
            __builtin_amdgcn_fence(__ATOMIC_RELEASE, "agent");
            asm volatile("s_waitcnt vmcnt(0)" ::: "memory");
            const unsigned og = xb_add(&bar[XB_TOP], 1u);
            const unsigned tg = og / nx;
            if (og + 1u == (tg + 1u) * nx) xb_add(&bar[XB_TOPGEN], 1u);
            else XB_SPIN(xb_ld(&bar[XB_TOPGEN]) == tg, bar);
            __builtin_amdgcn_fence(__ATOMIC_ACQUIRE, "agent");
            xb_add(&bar[XB_XGEN(b.x)], 1u);
            asm volatile("s_waitcnt vmcnt(0)" ::: "memory");
        } else {
            XB_SPIN(xb_ld(&bar[XB_XGEN(b.x)]) == gen, bar);
            __builtin_amdgcn_fence(__ATOMIC_ACQUIRE, "agent");
            asm volatile("s_waitcnt vmcnt(0)" ::: "memory");
        }
    }
    __syncthreads();
}
struct Frame {
    LAS unsigned char* lds;
    volatile LAS unsigned* MISC;
    gu32* ctl;
    int tid, lane, wave;
    int vcu, G;
};
template <int CTRL> __device__ __forceinline__ float dpp_f(float v) { return __builtin_bit_cast(float, __builtin_amdgcn_update_dpp(0, __builtin_bit_cast(int, v), CTRL, 0xf, 0xf, true)); }
__device__ __forceinline__ float wave_sum(float v) {
    v += dpp_f<0xB1>(v); v += dpp_f<0x4E>(v); v += dpp_f<0x141>(v); v += dpp_f<0x140>(v);
    { const auto s = __builtin_amdgcn_permlane16_swap(__float_as_uint(v), __float_as_uint(v), false, false); v = __uint_as_float(s[0]) + __uint_as_float(s[1]); }
    { const auto s = __builtin_amdgcn_permlane32_swap(__float_as_uint(v), __float_as_uint(v), false, false); v = __uint_as_float(s[0]) + __uint_as_float(s[1]); }
    return v;
}
__device__ __forceinline__ float rdlane(float v, int l) { return __builtin_bit_cast(float, __builtin_amdgcn_readlane(__builtin_bit_cast(int, v), l)); }
__device__ __forceinline__ float silu_f(float x) { return x / (1.f + __expf(-x)); }

__device__ __forceinline__ int win_src(int n) {
    if (n < 1024) { const int seg = n >> 9, c = n & 511, head = c >> 6, cc = c & 63; return seg * 512 + head * 64 + (cc >> 1) + 32 * (cc & 1); }
    if (n < 1536) return n;
    if (n < 1792) { const int c = n - 1536, head = c >> 5, cc = c & 31; return 1536 + head * 32 + (cc >> 1) + 16 * (cc & 1); }
    if (n < 2048) return 1832 + (n - 1792);
    if (n < 2304) return 2088 + (n - 2048);
    if (n < 2816) return 2344 + (n - 2304);
    if (n < 3328) return 2856 + (n - 2816);
    if (n < 3360) { const int cc = n - 3328; return 1792 + (cc >> 1) + 16 * (cc & 1); }
    if (n < 3368) return 1824 + (n - 3360);
    if (n < 3384) return n;
    return -1;
}
__device__ __forceinline__ int ei_src(int n) { return (n & 4) ? 512 + 4 * (n >> 3) + (n & 3) : 4 * (n >> 3) + (n & 3); }
template <int MODE> __device__ __forceinline__ void p0_transpose_item(const float* W, int K, int N, bf16* WT, LAS float* scr, int kb, int nb, int lane) {
    const int k0 = 64 * kb, n0 = 32 * nb;
    int sc = n0 + (lane & 31); if (MODE == 1) sc = win_src(sc); if (MODE == 2) sc = ei_src(sc);
#pragma unroll 8
    for (int i = 0; i < 32; ++i) { const int kk = 2 * i + (lane >> 5); scr[kk * 33 + (lane & 31)] = (sc >= 0) ? W[(size_t)(k0 + kk) * N + sc] : 0.f; }
    LDS_WAIT(); asm volatile("" ::: "memory");
    const int c = lane & 7;
#pragma unroll
    for (int j = 0; j < 4; ++j) { const int n = (lane >> 3) + 8 * j; const LAS float* s = scr + (8 * c) * 33 + n;
        v4u o; o.x = pk2(s[0 * 33], s[1 * 33]); o.y = pk2(s[2 * 33], s[3 * 33]); o.z = pk2(s[4 * 33], s[5 * 33]); o.w = pk2(s[6 * 33], s[7 * 33]);
        *(GAS v4u*)(WT + (size_t)(n0 + n) * K + k0 + 8 * c) = o; }
    LDS_WAIT(); asm volatile("" ::: "memory");
}
constexpr int BG_EI = 32 * 16 * 64, BG_EO = 32 * 16 * 32, BG_TASKS = BG_EI + BG_EO;
struct BgConv { int next, stride, cur; float v[16]; };
__device__ __forceinline__ void bg_decode(const Args& a, int id, int lane, const float*& src, bf16*& dst) {
    if (id < BG_EI) { const int e = id >> 10, rem = id & 1023, nb = rem >> 6, kb = rem & 63, n = nb * 64 + lane;
        src = a.in[12] + (size_t)e * 1024 * 1024 + (size_t)(kb * 16) * 1024 + ei_src(n); dst = (bf16*)(a.ws + WS_WEI) + (size_t)e * 1024 * 1024 + (size_t)n * 1024 + kb * 16; }
    else { const int id2 = id - BG_EI, e = id2 >> 9, rem = id2 & 511, nb = rem >> 5, kb = rem & 31, n = nb * 64 + lane;
        src = a.in[13] + (size_t)e * 512 * 1024 + (size_t)(kb * 16) * 1024 + n; dst = (bf16*)(a.ws + WS_WEO) + (size_t)e * 1024 * 512 + (size_t)n * 512 + kb * 16; }
}
__device__ __forceinline__ void bg_issue(const Args& a, BgConv& B, int lane) {
    if (B.cur < 0 && B.next < BG_TASKS) { const float* src; bf16* dst; bg_decode(a, B.next, lane, src, dst);
#pragma unroll
        for (int k = 0; k < 16; ++k) B.v[k] = src[(size_t)k * 1024];
        B.cur = B.next; B.next += B.stride; }
}
__device__ __forceinline__ void bg_retire(const Args& a, BgConv& B, int lane) {
    if (B.cur >= 0) { const float* src; bf16* dst; bg_decode(a, B.cur, lane, src, dst);
#pragma unroll
        for (int q = 0; q < 2; ++q) { v4u w; w.x = pk2(B.v[8 * q], B.v[8 * q + 1]); w.y = pk2(B.v[8 * q + 2], B.v[8 * q + 3]); w.z = pk2(B.v[8 * q + 4], B.v[8 * q + 5]); w.w = pk2(B.v[8 * q + 6], B.v[8 * q + 7]);
            *(v4u*)(dst + 8 * q) = w; }
        B.cur = -1; }
}
__device__ __forceinline__ void p0_prologue(Frame& F, const Args& a) {
    unsigned char* ws = a.ws;
    LAS float* scr = (LAS float*)(F.lds + RING_OFF + F.wave * 16384);
    const int gw = F.vcu * NWAVES + F.wave, NGW = F.G * NWAVES;
    constexpr int I_IN = 16 * (NPROJ / 32), I_O = 16 * 32;
    constexpr int NITEMS = I_IN + I_O;
    for (int it = gw; it < NITEMS; it += NGW) {
        int r = it;
        if (r < I_IN) { p0_transpose_item<1>(a.in[1], D, IN_W, (bf16*)(ws + WS_WIN), scr, r / (NPROJ / 32), r % (NPROJ / 32), F.lane); continue; } r -= I_IN;
        p0_transpose_item<0>(a.in[5], D, D, (bf16*)(ws + WS_WO), scr, r / 32, r % 32, F.lane);
    }
    for (int m0 = 4 * gw; m0 < M; m0 += 4 * NGW) {
        f32x4 v[4][4];
#pragma unroll
        for (int r = 0; r < 4; ++r) { const GAS f32x4* xr = (const GAS f32x4*)(a.in[0] + (size_t)(m0 + r) * D) + F.lane;
#pragma unroll
            for (int j = 0; j < 4; ++j) v[r][j] = xr[64 * j]; }
#pragma unroll
        for (int r = 0; r < 4; ++r) { GAS v2u* o8 = (GAS v2u*)((bf16*)(ws + WS_XB) + (size_t)(m0 + r) * D) + F.lane;
#pragma unroll
            for (int j = 0; j < 4; ++j) { v2u w; w.x = pk2(v[r][j].x, v[r][j].y); w.y = pk2(v[r][j].z, v[r][j].w); o8[64 * j] = w; } }
    }
    const int gt = F.vcu * (NWAVES * 64) + F.tid, NGT = F.G * NWAVES * 64;
    for (int i = gt; i < T * 48; i += NGT) {
        const int pos = i / 48, jj = i % 48; const bool big = jj < 32; const int j = big ? jj : jj - 32;
        const double r = big ? 0.74989420933245582730   : 0.56234132519034908039  ;
        double inv = 1.0; for (int k = 0; k < j; ++k) inv *= r;
        const double rev = (double)pos * inv * 0.15915494309189533577; const float f = (float)(rev - __builtin_floor(rev));
        const float c = __builtin_amdgcn_cosf(f), s = __builtin_amdgcn_sinf(f);
        if (big) { ((float*)(ws + WS_COS64))[pos * 32 + j] = c; ((float*)(ws + WS_SIN64))[pos * 32 + j] = s; }
        else { ((float*)(ws + WS_COS32))[pos * 16 + j] = c; ((float*)(ws + WS_SIN32))[pos * 16 + j] = s; }
    }
}
struct EpiProj {
    static constexpr bool PERM = true, AFTER_DRAIN = false;
    unsigned char* ws;
    static __device__ __forceinline__ void rope4(f32x4& v0, f32x4& v1, const f32x4 c, const f32x4 s) {
        const f32x4 a = v0, b = v1;
        v0[0] = a[0] * c[0] - a[1] * s[0]; v0[1] = a[1] * c[0] + a[0] * s[0];
        v0[2] = a[2] * c[1] - a[3] * s[1]; v0[3] = a[3] * c[1] + a[2] * s[1];
        v1[0] = b[0] * c[2] - b[1] * s[2]; v1[1] = b[1] * c[2] + b[0] * s[2];
        v1[2] = b[2] * c[3] - b[3] * s[3]; v1[3] = b[3] * c[3] + b[2] * s[3];
    }
    template <int SEG> __device__ __forceinline__ void emit(const f32x4 (&acc)[2][2][4][2], const pg8::Unit& u, int wr, int wc, int fr, int fq) const {
        const int row0 = u.pm * 256 + wr * 64 + fr;
#pragma unroll
        for (int ai = 0; ai < 2; ++ai)
#pragma unroll
            for (int m = 0; m < 4; ++m) {
                const int r = row0 + ai * 128 + m * 16, pos = r & (T - 1);
#pragma unroll
                for (int bj = 0; bj < 2; ++bj) {
                    const int cg = u.pn * 256 + bj * 128 + wc * 32 + 8 * fq;
                    f32x4 v0 = acc[ai][bj][m][0], v1 = acc[ai][bj][m][1];
                    if (SEG == 0 || SEG == 1) {
                        const int j0 = (cg & 63) >> 1;
                        const f32x4 c = *(const f32x4*)((const float*)(ws + WS_COS64) + pos * 32 + j0), s = *(const f32x4*)((const float*)(ws + WS_SIN64) + pos * 32 + j0);
                        rope4(v0, v1, c, s);
                        if (SEG == 0) { v0 = v0 * QK_C2; v1 = v1 * QK_C2; }
                        v4u w; w.x = pk2(v0[0], v0[1]); w.y = pk2(v0[2], v0[3]); w.z = pk2(v1[0], v1[1]); w.w = pk2(v1[2], v1[3]);
                        *(v4u*)((bf16*)(ws + (SEG == 0 ? WS_AQ : WS_AK)) + (size_t)r * 512 + (cg & 511)) = w;
                    } else if (SEG == 2 || SEG == 6 || SEG == 7) {
                        const size_t base = SEG == 2 ? WS_AV : (SEG == 6 ? WS_BV : WS_BR); const int c0 = SEG == 2 ? 1024 : (SEG == 6 ? 2304 : 2816);
                        v4u w; w.x = pk2(v0[0], v0[1]); w.y = pk2(v0[2], v0[3]); w.z = pk2(v1[0], v1[1]); w.w = pk2(v1[2], v1[3]);
                        *(v4u*)((bf16*)(ws + base) + (size_t)r * 512 + (cg - c0)) = w;
                    } else if (SEG == 3) {
                        const int j0 = (cg & 31) >> 1;
                        const f32x4 c = *(const f32x4*)((const float*)(ws + WS_COS32) + pos * 16 + j0), s = *(const f32x4*)((const float*)(ws + WS_SIN32) + pos * 16 + j0);
                        rope4(v0, v1, c, s);
                        v4u w; w.x = pkh2(v0[0], v0[1]); w.y = pkh2(v0[2], v0[3]); w.z = pkh2(v1[0], v1[1]); w.w = pkh2(v1[2], v1[3]);
                        *(v4u*)((unsigned short*)(ws + WS_IQ) + (size_t)r * 256 + (cg - 1536)) = w;
                    } else if (SEG == 4 || SEG == 5) {
                        if (SEG == 4) { v0 = v0 * 0.125f; v1 = v1 * 0.125f; }
                        v4u w; w.x = pk2(v0[0], v0[1]); w.y = pk2(v0[2], v0[3]); w.z = pk2(v1[0], v1[1]); w.w = pk2(v1[2], v1[3]);
                        *(v4u*)((bf16*)(ws + (SEG == 4 ? WS_BQ : WS_BK)) + (size_t)r * 256 + (cg - (SEG == 4 ? 1792 : 2048))) = w;
                    } else {
                        const int tc = cg - 3328;
                        if (tc < 32) {
                            const int j0 = tc >> 1;
                            const f32x4 c = *(const f32x4*)((const float*)(ws + WS_COS32) + pos * 16 + j0), s = *(const f32x4*)((const float*)(ws + WS_SIN32) + pos * 16 + j0);
                            rope4(v0, v1, c, s);
                            v4u w; w.x = pkh2(v0[0], v0[1]); w.y = pkh2(v0[2], v0[3]); w.z = pkh2(v1[0], v1[1]); w.w = pkh2(v1[2], v1[3]);
                            *(v4u*)((unsigned short*)(ws + WS_IK) + (size_t)r * 32 + tc) = w;
                        } else if (tc < 40) {
                            float* p = (float*)(ws + WS_IW) + (size_t)r * 8; *(f32x4*)p = v0 * IDX_SCALE; *(f32x4*)(p + 4) = v1 * IDX_SCALE;
                        } else if (tc < 56) {
                            float* p = (float*)(ws + WS_BG) + (size_t)r * 16 + (tc - 40); *(f32x4*)p = v0; *(f32x4*)(p + 4) = v1;
                        }
                    }
                }
            }
    }
    __device__ __forceinline__ void operator()(const f32x4 (&acc)[2][2][4][2], const pg8::Unit& u, int wr, int wc, int fr, int fq) const {
        switch (u.pn) {
            case 0: case 1: emit<0>(acc, u, wr, wc, fr, fq); break;
            case 2: case 3: emit<1>(acc, u, wr, wc, fr, fq); break;
            case 4: case 5: emit<2>(acc, u, wr, wc, fr, fq); break;
            case 6: emit<3>(acc, u, wr, wc, fr, fq); break;
            case 7: emit<4>(acc, u, wr, wc, fr, fq); break;
            case 8: emit<5>(acc, u, wr, wc, fr, fq); break;
            case 9: case 10: emit<6>(acc, u, wr, wc, fr, fq); break;
            case 11: case 12: emit<7>(acc, u, wr, wc, fr, fq); break;
            default: emit<8>(acc, u, wr, wc, fr, fq); break;
        }
    }
};
struct EpiMixBf16 {
    static constexpr bool PERM = true, AFTER_DRAIN = false;
    bf16* C;
    __device__ __forceinline__ void operator()(const f32x4 (&acc)[2][2][4][2], const pg8::Unit& u, int wr, int wc, int fr, int fq) const {
        const int row0 = u.pm * 256 + wr * 64 + fr, col0 = u.pn * 256 + wc * 32 + 8 * fq;
#pragma unroll
        for (int ai = 0; ai < 2; ++ai)
#pragma unroll
            for (int m = 0; m < 4; ++m) { bf16* rowp = C + (size_t)(row0 + ai * 128 + m * 16) * 1024 + col0;
#pragma unroll
                for (int bj = 0; bj < 2; ++bj) { const f32x4 v0 = acc[ai][bj][m][0], v1 = acc[ai][bj][m][1];
                    v4u w; w.x = pk2(v0[0], v0[1]); w.y = pk2(v0[2], v0[3]); w.z = pk2(v1[0], v1[1]); w.w = pk2(v1[2], v1[3]);
                    *(v4u*)(rowp + bj * 128) = w; } }
    }
};
constexpr int GL_GT = 0, GL_RS = 2048, GL_QG = 4096, GL_KG = GL_QG + 9216, GL_KD = GL_KG + 9216, GL_V = 32768;
constexpr int GL_S64 = 144, GL_SV = 272;
typedef short v4i16_t __attribute__((ext_vector_type(4)));
__device__ __forceinline__ bf16x8 tr_frag(LAS const unsigned char* img, int stride, int r0a, int r0b, int c0, int lane) {
    const int q = (lane & 15) >> 2, p = lane & 3;
    const s16x4 lo = __builtin_bit_cast(s16x4, __builtin_amdgcn_ds_read_tr16_b64_v4i16((LAS v4i16_t*)(img + (r0a + q) * stride + (c0 + 4 * p) * 2)));
    const s16x4 hi = __builtin_bit_cast(s16x4, __builtin_amdgcn_ds_read_tr16_b64_v4i16((LAS v4i16_t*)(img + (r0b + q) * stride + (c0 + 4 * p) * 2)));
    return (bf16x8){lo[0], lo[1], lo[2], lo[3], hi[0], hi[1], hi[2], hi[3]};
}
struct GlaRaw { float w[16]; float bias, bv0, bv1; unsigned short k[8], q[8]; v4u v[2]; };
template <bool WITH_Q> __device__ __forceinline__ void gla_fetch(const Args& a, int uu, int tid, int lane, int g, GlaRaw& R) {
    const int h = uu & 3, t0 = (uu >> 2) * 64, d = tid & 63;
    const float* Wg = a.in[2]; const float* BG = (const float*)(a.ws + WS_BG);
    const bf16* BQ = (const bf16*)(a.ws + WS_BQ); const bf16* BK = (const bf16*)(a.ws + WS_BK); const bf16* BV = (const bf16*)(a.ws + WS_BV);
#pragma unroll
    for (int r = 0; r < 16; ++r) R.w[r] = Wg[r * 256 + h * 64 + d];
    R.bias = a.in[3][h * 64 + d];
    R.bv0 = BG[(size_t)(t0 + 8 * g + (lane >> 4)) * 16 + (lane & 15)];
    R.bv1 = BG[(size_t)(t0 + 8 * g + 4 + (lane >> 4)) * 16 + (lane & 15)];
#pragma unroll
    for (int jj = 0; jj < 8; ++jj) { R.k[jj] = BK[(size_t)(t0 + 8 * g + jj) * 256 + h * 64 + d]; if (WITH_Q) R.q[jj] = BQ[(size_t)(t0 + 8 * g + jj) * 256 + h * 64 + d]; }
#pragma unroll
    for (int i = 0; i < 2; ++i) { const int p = tid + 512 * i, row = p >> 4, cp = p & 15; R.v[i] = *(const v4u*)(BV + (size_t)(t0 + row) * 512 + h * 128 + cp * 8); }
}
__device__ __forceinline__ void gla_gate(const GlaRaw& R, LAS float* GT, int tid, int g, float (&b)[8], float& blast) {
    const int d = tid & 63;
    float run = 0.f;
#pragma unroll
    for (int jj = 0; jj < 8; ++jj) {
        float z = R.bias;
#pragma unroll
        for (int r = 0; r < 16; ++r) z += rdlane(jj < 4 ? R.bv0 : R.bv1, (jj & 3) * 16 + r) * R.w[r];
        z = fmaxf(z, -80.f);
        const float la = -__logf(1.f + __expf(-z)) * (1.f / 16.f);
        run += la; b[jj] = run;
    }
    GT[g * 64 + d] = run;
    __syncthreads();
    float off = 0.f, tot = 0.f;
#pragma unroll
    for (int gg = 0; gg < 8; ++gg) { const float v = GT[gg * 64 + d]; tot += v; if (gg < g) off += v; }
#pragma unroll
    for (int jj = 0; jj < 8; ++jj) b[jj] += off;
    blast = tot;
}
__device__ __forceinline__ void gla_put_v(const GlaRaw& R, LAS unsigned char* L, int tid) {
#pragma unroll
    for (int i = 0; i < 2; ++i) { const int p = tid + 512 * i, row = p >> 4, cp = p & 15; *(LAS v4u*)(L + GL_V + row * GL_SV + cp * 16) = R.v[i]; }
}
__device__ __forceinline__ void gla_phase_a(Frame& F, const Args& a, float* KVT, float* DEC) {
    LAS unsigned char* L = F.lds + RING_OFF;
    const int tid = F.tid, lane = F.lane, g = F.wave, d = tid & 63, fq = lane >> 4;
    for (int u = F.vcu * 8; u < 2048; u += F.G * 8) {
        GlaRaw R; gla_fetch<false>(a, u, tid, lane, g, R);
        for (int uu = u; uu < u + 8; ++uu) {
            float b[8], blast;
            gla_gate(R, (LAS float*)(L + GL_GT), tid, g, b, blast);
#pragma unroll
            for (int jj = 0; jj < 8; ++jj) { const int j = 8 * g + jj;
                *(LAS unsigned short*)(L + GL_KD + j * GL_S64 + d * 2) = (unsigned short)f2bf(bf2f(R.k[jj]) * __expf(blast - b[jj])); }
            gla_put_v(R, L, tid);
            if (g == 0) DEC[uu * 64 + d] = __expf(blast);
            if (uu + 1 < u + 8) gla_fetch<false>(a, uu + 1, tid, lane, g, R);
            __syncthreads();
            const int vt = g;
            const bf16x8 a0 = tr_frag(L + GL_V, GL_SV, 8 * fq, 8 * fq + 4, 16 * vt, lane), a1 = tr_frag(L + GL_V, GL_SV, 32 + 8 * fq, 36 + 8 * fq, 16 * vt, lane);
#pragma unroll
            for (int dt = 0; dt < 4; ++dt) {
                const bf16x8 b0 = tr_frag(L + GL_KD, GL_S64, 8 * fq, 8 * fq + 4, 16 * dt, lane), b1 = tr_frag(L + GL_KD, GL_S64, 32 + 8 * fq, 36 + 8 * fq, 16 * dt, lane);
                f32x4 acc = {0.f, 0.f, 0.f, 0.f};
                acc = __builtin_amdgcn_mfma_f32_16x16x32_bf16(a0, b0, acc, 0, 0, 0);
                acc = __builtin_amdgcn_mfma_f32_16x16x32_bf16(a1, b1, acc, 0, 0, 0);
#pragma unroll
                for (int r = 0; r < 4; ++r) KVT[(size_t)uu * 8192 + (16 * vt + 4 * fq + r) * 64 + 16 * dt + (lane & 15)] = acc[r];
            }
        }
    }
    __syncthreads();
}
__device__ __forceinline__ void gla_phase_b(Frame& F, const float* KVT, const float* DEC, bf16* SPREV) {
    for (int it = F.vcu; it < 256; it += F.G) {
        const int bh = it >> 4, part = it & 15, idx = part * 512 + F.tid, d = idx & 63, bb = bh >> 2, h = bh & 3;
        float S = 0.f;
        for (int n0 = 0; n0 < NCHUNK; n0 += 8) {
            float kv[8], dc[8];
#pragma unroll
            for (int k = 0; k < 8; ++k) { const int u = (bb * NCHUNK + n0 + k) * 4 + h; kv[k] = KVT[(size_t)u * 8192 + idx]; dc[k] = DEC[u * 64 + d]; }
#pragma unroll
            for (int k = 0; k < 8; ++k) { const int u = (bb * NCHUNK + n0 + k) * 4 + h; SPREV[(size_t)u * 8192 + idx] = (bf16)f2bf(S); S = dc[k] * S + kv[k]; }
        }
    }
}
struct GlaRawC { bf16x8 sa[4][2]; v2u br[4]; };
__device__ __forceinline__ void gla_fetch_c(const Args& a, const bf16* SPREV, int uu, int lane, int g, GlaRawC& C) {
    const int h = uu & 3, t0 = (uu >> 2) * 64, it = g & 3, vh = g >> 2, l15 = lane & 15, fq = lane >> 4;
    const bf16* BR = (const bf16*)(a.ws + WS_BR);
#pragma unroll
    for (int k = 0; k < 4; ++k) { const int vt = 4 * vh + k;
#pragma unroll
        for (int s = 0; s < 2; ++s) C.sa[k][s] = *(const bf16x8*)(SPREV + (size_t)uu * 8192 + (16 * vt + l15) * 64 + 32 * s + 8 * fq);
        C.br[k] = *(const v2u*)(BR + (size_t)(t0 + 16 * it + l15) * 512 + h * 128 + 16 * vt + 4 * fq); }
}
__device__ __forceinline__ void gla_phase_c(Frame& F, const Args& a, const bf16* SPREV) {
    LAS unsigned char* L = F.lds + RING_OFF;
    const int tid = F.tid, lane = F.lane, g = F.wave, d = tid & 63, fq = lane >> 4, l15 = lane & 15;
    bf16* Y = (bf16*)(a.ws + WS_Y); const float* gn = a.in[4];
    LAS float* RS = (LAS float*)(L + GL_RS);
    const int it = g & 3, vh = g >> 2;
    f32x4 gv[4];
#pragma unroll
    for (int k = 0; k < 4; ++k) gv[k] = *(const f32x4*)(gn + 16 * (4 * vh + k) + 4 * fq);
    for (int u = F.vcu * 8; u < 2048; u += F.G * 8) {
        GlaRaw R; GlaRawC C; gla_fetch<true>(a, u, tid, lane, g, R); gla_fetch_c(a, SPREV, u, lane, g, C);
        for (int uu = u; uu < u + 8; ++uu) {
            const int h = uu & 3, t0 = (uu >> 2) * 64;
            float b[8], blast;
            gla_gate(R, (LAS float*)(L + GL_GT), tid, g, b, blast);
#pragma unroll
            for (int jj = 0; jj < 8; ++jj) { const int j = 8 * g + jj; const float e = __expf(b[jj]);
                *(LAS unsigned short*)(L + GL_QG + j * GL_S64 + d * 2) = (unsigned short)f2bf(bf2f(R.q[jj]) * e);
                *(LAS unsigned short*)(L + GL_KG + j * GL_S64 + d * 2) = (unsigned short)f2bf(bf2f(R.k[jj]) * __builtin_amdgcn_rcpf(e)); }
            gla_put_v(R, L, tid);
            const GlaRawC Cc = C;
            if (uu + 1 < u + 8) { gla_fetch<true>(a, uu + 1, tid, lane, g, R); gla_fetch_c(a, SPREV, uu + 1, lane, g, C); }
            __syncthreads();
            bf16x8 qf[2];
#pragma unroll
            for (int s = 0; s < 2; ++s) qf[s] = *(LAS const bf16x8*)(L + GL_QG + (16 * it + l15) * GL_S64 + (32 * s + 8 * fq) * 2);
            f32x4 at[4];
#pragma unroll
            for (int jt = 0; jt < 4; ++jt) {
                f32x4 acc = {0.f, 0.f, 0.f, 0.f};
                if (jt <= it) {
#pragma unroll
                    for (int s = 0; s < 2; ++s) { const bf16x8 kf = *(LAS const bf16x8*)(L + GL_KG + (16 * jt + l15) * GL_S64 + (32 * s + 8 * fq) * 2);
                        acc = __builtin_amdgcn_mfma_f32_16x16x32_bf16(kf, qf[s], acc, 0, 0, 0); }
#pragma unroll
                    for (int r = 0; r < 4; ++r) if (16 * jt + 4 * fq + r > 16 * it + l15) acc[r] = 0.f;
                }
                at[jt] = acc;
            }
            bf16x8 af[2];
#pragma unroll
            for (int s = 0; s < 2; ++s) { v4u w; w.x = pk2(at[2 * s][0], at[2 * s][1]); w.y = pk2(at[2 * s][2], at[2 * s][3]); w.z = pk2(at[2 * s + 1][0], at[2 * s + 1][1]); w.w = pk2(at[2 * s + 1][2], at[2 * s + 1][3]);
                af[s] = __builtin_bit_cast(bf16x8, w); }
            f32x4 o[4]; float ssq = 0.f;
#pragma unroll
            for (int k = 0; k < 4; ++k) { const int vt = 4 * vh + k;
                f32x4 acc = {0.f, 0.f, 0.f, 0.f};
#pragma unroll
                for (int s = 0; s < 2; ++s) { const bf16x8 va = tr_frag(L + GL_V, GL_SV, 32 * s + 4 * fq, 32 * s + 16 + 4 * fq, 16 * vt, lane);
                    acc = __builtin_amdgcn_mfma_f32_16x16x32_bf16(va, af[s], acc, 0, 0, 0); }
#pragma unroll
                for (int s = 0; s < 2; ++s) acc = __builtin_amdgcn_mfma_f32_16x16x32_bf16(Cc.sa[k][s], qf[s], acc, 0, 0, 0);
                o[k] = acc; ssq += (acc[0] * acc[0] + acc[1] * acc[1]) + (acc[2] * acc[2] + acc[3] * acc[3]);
            }
            ssq += __shfl_xor(ssq, 16); ssq += __shfl_xor(ssq, 32);
            if (fq == 0) RS[vh * 64 + 16 * it + l15] = ssq;
            __syncthreads();
            const float tot = RS[16 * it + l15] + RS[64 + 16 * it + l15];
            const float rstd = 1.f / sqrtf(tot * (1.f / 128.f) + LN_EPS);
            const int tok = t0 + 16 * it + l15;
#pragma unroll
            for (int k = 0; k < 4; ++k) { const int v0 = 16 * (4 * vh + k) + 4 * fq;
                const v2u brw = Cc.br[k];
                const float r0 = bf2f((unsigned short)(brw.x & 0xffffu)), r1 = bf2f((unsigned short)(brw.x >> 16)), r2 = bf2f((unsigned short)(brw.y & 0xffffu)), r3 = bf2f((unsigned short)(brw.y >> 16));
                v2u w; w.x = pk2(o[k][0] * rstd * gv[k][0] * silu_f(r0), o[k][1] * rstd * gv[k][1] * silu_f(r1)); w.y = pk2(o[k][2] * rstd * gv[k][2] * silu_f(r2), o[k][3] * rstd * gv[k][3] * silu_f(r3));
                *(v2u*)(Y + (size_t)tok * 1024 + 512 + h * 128 + v0) = w; }
        }
    }
    __syncthreads();
}
__device__ __forceinline__ void ln1_tile(Frame& F, const Args& a, const bf16* MIX, float* H, bf16* HB, int tile) {
    const float* x = a.in[0];
    f32x4 g[4], bb[4];
#pragma unroll
    for (int j = 0; j < 4; ++j) { g[j] = ((const GAS f32x4*)a.in[6])[F.lane + 64 * j]; bb[j] = ((const GAS f32x4*)a.in[7])[F.lane + 64 * j]; }
    for (int m0 = 16 * tile; m0 < 16 * tile + 16; m0 += 2) {
        f32x4 v[2][4]; float s[2];
#pragma unroll
        for (int r = 0; r < 2; ++r) { const int m = m0 + r;
            const GAS f32x4* xr = (const GAS f32x4*)(x + (size_t)m * D) + F.lane; const GAS v2u* mr = (const GAS v2u*)(MIX + (size_t)m * D) + F.lane;
            s[r] = 0.f;
#pragma unroll
            for (int j = 0; j < 4; ++j) { const v2u mw = mr[64 * j]; const f32x4 mx = {bf2f((unsigned short)(mw.x & 0xffffu)), bf2f((unsigned short)(mw.x >> 16)), bf2f((unsigned short)(mw.y & 0xffffu)), bf2f((unsigned short)(mw.y >> 16))};
                v[r][j] = xr[64 * j] * ALPHA + mx; s[r] += (v[r][j].x + v[r][j].y) + (v[r][j].z + v[r][j].w); } }
        float mean[2], s2[2], rstd[2];
#pragma unroll
        for (int r = 0; r < 2; ++r) mean[r] = wave_sum(s[r]) * (1.f / D);
#pragma unroll
        for (int r = 0; r < 2; ++r) { s2[r] = 0.f;
#pragma unroll
            for (int j = 0; j < 4; ++j) { v[r][j] = v[r][j] - mean[r]; s2[r] += (v[r][j].x * v[r][j].x + v[r][j].y * v[r][j].y) + (v[r][j].z * v[r][j].z + v[r][j].w * v[r][j].w); } }
#pragma unroll
        for (int r = 0; r < 2; ++r) rstd[r] = 1.f / sqrtf(wave_sum(s2[r]) * (1.f / D) + LN_EPS);
#pragma unroll
        for (int r = 0; r < 2; ++r) { const int m = m0 + r;
            GAS f32x4* hr = (GAS f32x4*)(H + (size_t)m * D) + F.lane; GAS v2u* o8 = (GAS v2u*)(HB + (size_t)m * D) + F.lane;
#pragma unroll
            for (int j = 0; j < 4; ++j) { const f32x4 o = v[r][j] * rstd[r] * g[j] + bb[j]; hr[64 * j] = o; v2u w; w.x = pk2(o.x, o.y); w.y = pk2(o.z, o.w); o8[64 * j] = w; } }
    }
}
__device__ __forceinline__ void ln2_phase(Frame& F, const Args& a, float* H, const bf16* HBp, const bf16* FFN2) {
    const int gw = F.vcu * NWAVES + F.wave, NGW = F.G * NWAVES;
    f32x4 g[4], bb[4];
#pragma unroll
    for (int j = 0; j < 4; ++j) { g[j] = ((const GAS f32x4*)a.in[14])[F.lane + 64 * j]; bb[j] = ((const GAS f32x4*)a.in[15])[F.lane + 64 * j]; }
    for (int m0 = 2 * gw; m0 < M; m0 += 2 * NGW) {
        f32x4 v[2][4]; float s[2];
#pragma unroll
        for (int r = 0; r < 2; ++r) { const int m = m0 + r;
            const GAS v2u* hb = (const GAS v2u*)(HBp + (size_t)m * D) + F.lane;
            const GAS v2u* f0 = (const GAS v2u*)(FFN2 + (size_t)(2 * m) * D) + F.lane; const GAS v2u* f1 = (const GAS v2u*)(FFN2 + (size_t)(2 * m + 1) * D) + F.lane;
            s[r] = 0.f;
#pragma unroll
            for (int j = 0; j < 4; ++j) { const v2u p = f0[64 * j], q = f1[64 * j]; const v2u hw = hb[64 * j]; f32x4 t = (f32x4){bf2f((unsigned short)(hw.x & 0xffffu)), bf2f((unsigned short)(hw.x >> 16)), bf2f((unsigned short)(hw.y & 0xffffu)), bf2f((unsigned short)(hw.y >> 16))} * ALPHA;
                t.x += bf2f((unsigned short)(p.x & 0xffffu)) + bf2f((unsigned short)(q.x & 0xffffu)); t.y += bf2f((unsigned short)(p.x >> 16)) + bf2f((unsigned short)(q.x >> 16));
                t.z += bf2f((unsigned short)(p.y & 0xffffu)) + bf2f((unsigned short)(q.y & 0xffffu)); t.w += bf2f((unsigned short)(p.y >> 16)) + bf2f((unsigned short)(q.y >> 16));
                v[r][j] = t; s[r] += (t.x + t.y) + (t.z + t.w); } }
        float mean[2], s2[2], rstd[2];
#pragma unroll
        for (int r = 0; r < 2; ++r) mean[r] = wave_sum(s[r]) * (1.f / D);
#pragma unroll
        for (int r = 0; r < 2; ++r) { s2[r] = 0.f;
#pragma unroll
            for (int j = 0; j < 4; ++j) { v[r][j] = v[r][j] - mean[r]; s2[r] += (v[r][j].x * v[r][j].x + v[r][j].y * v[r][j].y) + (v[r][j].z * v[r][j].z + v[r][j].w * v[r][j].w); } }
#pragma unroll
        for (int r = 0; r < 2; ++r) rstd[r] = 1.f / sqrtf(wave_sum(s2[r]) * (1.f / D) + LN_EPS);
#pragma unroll
        for (int r = 0; r < 2; ++r) { GAS f32x4* hr = (GAS f32x4*)(H + (size_t)(m0 + r) * D) + F.lane;
#pragma unroll
            for (int j = 0; j < 4; ++j) hr[64 * j] = v[r][j] * rstd[r] * g[j] + bb[j]; }
    }
}
__device__ __forceinline__ void zero_ya(Frame& F, const Args& a) {
    const int gt = F.vcu * (NWAVES * 64) + F.tid, NGT = F.G * NWAVES * 64;
    bf16* Y = (bf16*)(a.ws + WS_Y);
    for (int i = gt; i < M * 64; i += NGT) { const int r = i >> 6, c = i & 63; *(v4u*)(Y + (size_t)r * 1024 + c * 8) = (v4u){0u, 0u, 0u, 0u}; }
}
constexpr size_t WS_WRH = WS_MOE, WS_WRL = WS_MOE + 128 * 1024, WS_EID = WS_MOE + 512 * 1024, WS_GATE = WS_MOE + 1024 * 1024, WS_CNT = WS_MOE + 1536 * 1024,
                 WS_OFFS = WS_MOE + 1536 * 1024 + 64 * 1024, WS_DEST = WS_MOE + 2048 * 1024, WS_GPOS = WS_MOE + 2560 * 1024, WS_TOKROW = WS_MOE + 3072 * 1024;
constexpr int MOE_MAXTILES = 288;
constexpr int TILEE_OFF = MISC_OFF + 256;
__device__ __forceinline__ void p0_router_weights(Frame& F, const Args& a) {
    const int gt = F.vcu * (NWAVES * 64) + F.tid, NGT = F.G * NWAVES * 64;
    bf16* WH = (bf16*)(a.ws + WS_WRH); bf16* WL = (bf16*)(a.ws + WS_WRL);
    for (int i = gt; i < 48 * 1024; i += NGT) { const int c = i >> 10, k = i & 1023;
        const float w = c < 4 ? a.in[8][k * 4 + c] : (c < 36 ? a.in[10][k * 32 + (c - 4)] : 0.f);
        const unsigned hi = f2bf(w); const float rem = w - bf2f((unsigned short)hi);
        WH[i] = (bf16)hi; WL[i] = (bf16)f2bf(rem); }
}
constexpr int RT_ROW = 272, RT_HL = 48 * RT_ROW, RT_BUF = 2 * RT_HL;
__device__ __forceinline__ void moe_ln1_route_phase(Frame& F, const Args& a, const bf16* MIX, float* H, bf16* HB) {
    LAS unsigned char* L = F.lds + RING_OFF;
    LAS float* LG = (LAS float*)(L + 2 * RT_BUF + F.wave * 4096);
    LAS unsigned* lcnt = (LAS unsigned*)(L + 2 * RT_BUF + 8 * 4096);
    const int lane = F.lane, l15 = lane & 15, fq = lane >> 4, tid = F.tid;
    const bf16* WH = (const bf16*)(a.ws + WS_WRH); const bf16* WL = (const bf16*)(a.ws + WS_WRL);
    int* EID = (int*)(a.ws + WS_EID); float* GATE = (float*)(a.ws + WS_GATE); int* CNT = (int*)(a.ws + WS_CNT);
    const bf16* bsrc[3]; int bdst[3];
#pragma unroll
    for (int i = 0; i < 3; ++i) { const int p = tid + 512 * i, hl = p / 768, rem = p % 768, row = rem >> 4, cp = rem & 15;
        bsrc[i] = (hl ? WL : WH) + (size_t)row * 1024 + cp * 8; bdst[i] = hl * RT_HL + row * RT_ROW + cp * 16; }
    for (int vb = F.vcu; vb < 256; vb += F.G) {
        if (tid < 32) lcnt[tid] = 0u;
        const int tile = vb * 8 + F.wave;
        ln1_tile(F, a, MIX, H, HB, tile);
        VM_WAIT();
        f32x4 acc[3]; acc[0] = acc[1] = acc[2] = (f32x4){0.f, 0.f, 0.f, 0.f};
        const float* hrow = H + (size_t)(16 * tile + l15) * D + 8 * fq;
        v4u breg[3]; f32x4 xa[4][2];
#pragma unroll
        for (int i = 0; i < 3; ++i) breg[i] = *(const v4u*)(bsrc[i]);
#pragma unroll
        for (int u = 0; u < 4; ++u) { xa[u][0] = *(const f32x4*)(hrow + 32 * u); xa[u][1] = *(const f32x4*)(hrow + 32 * u + 4); }
#pragma unroll
        for (int i = 0; i < 3; ++i) *(LAS v4u*)(L + bdst[i]) = breg[i];
        for (int ch = 0; ch < 8; ++ch) {
            LAS unsigned char* cur = L + (ch & 1) * RT_BUF; LAS unsigned char* nxt = L + ((ch & 1) ^ 1) * RT_BUF;
            __syncthreads();
            f32x4 xc[4][2];
#pragma unroll
            for (int u = 0; u < 4; ++u) { xc[u][0] = xa[u][0]; xc[u][1] = xa[u][1]; }
            if (ch < 7) {
#pragma unroll
                for (int i = 0; i < 3; ++i) breg[i] = *(const v4u*)(bsrc[i] + 128 * (ch + 1));
#pragma unroll
                for (int u = 0; u < 4; ++u) { xa[u][0] = *(const f32x4*)(hrow + 128 * (ch + 1) + 32 * u); xa[u][1] = *(const f32x4*)(hrow + 128 * (ch + 1) + 32 * u + 4); }
            }
#pragma unroll
            for (int u = 0; u < 4; ++u) {
                const float xs[8] = {xc[u][0][0], xc[u][0][1], xc[u][0][2], xc[u][0][3], xc[u][1][0], xc[u][1][1], xc[u][1][2], xc[u][1][3]};
                unsigned hw[4], lw[4];
#pragma unroll
                for (int p = 0; p < 4; ++p) { const unsigned h0 = f2bf(xs[2 * p]), h1 = f2bf(xs[2 * p + 1]);
                    hw[p] = h0 | (h1 << 16); lw[p] = pk2(xs[2 * p] - bf2f((unsigned short)h0), xs[2 * p + 1] - bf2f((unsigned short)h1)); }
                const bf16x8 ah = __builtin_bit_cast(bf16x8, (v4u){hw[0], hw[1], hw[2], hw[3]}), al = __builtin_bit_cast(bf16x8, (v4u){lw[0], lw[1], lw[2], lw[3]});
#pragma unroll
                for (int nt = 0; nt < 3; ++nt) {
                    const bf16x8 bh = *(LAS const bf16x8*)(cur + (16 * nt + l15) * RT_ROW + (32 * u + 8 * fq) * 2), bl = *(LAS const bf16x8*)(cur + RT_HL + (16 * nt + l15) * RT_ROW + (32 * u + 8 * fq) * 2);
                    acc[nt] = __builtin_amdgcn_mfma_f32_16x16x32_bf16(ah, bh, acc[nt], 0, 0, 0);
                    acc[nt] = __builtin_amdgcn_mfma_f32_16x16x32_bf16(ah, bl, acc[nt], 0, 0, 0);
                    acc[nt] = __builtin_amdgcn_mfma_f32_16x16x32_bf16(al, bh, acc[nt], 0, 0, 0);
                }
            }
            if (ch < 7) {
#pragma unroll
                for (int i = 0; i < 3; ++i) *(LAS v4u*)(nxt + bdst[i]) = breg[i];
            }
        }
#pragma unroll
        for (int nt = 0; nt < 3; ++nt)
#pragma unroll
            for (int r = 0; r < 4; ++r) LG[(4 * fq + r) * 48 + 16 * nt + l15] = acc[nt][r];
        LDS_WAIT(); asm volatile("" ::: "memory");
        if (lane < 16) {
            const int tok = 16 * tile + lane; const LAS float* lg = LG + lane * 48;
            float gl[4]; int gs = 0; float gm = -INFINITY;
#pragma unroll
            for (int c = 0; c < 4; ++c) { gl[c] = lg[c] + a.in[9][c]; if (gl[c] > gm) { gm = gl[c]; gs = c; } }
            float den = 0.f;
#pragma unroll
            for (int c = 0; c < 4; ++c) den += __expf(gl[c] - gm);
            const float pg = 1.f / den;
            float t0v = -INFINITY, t1v = -INFINITY; int t0i = 0, t1i = 0;
            for (int c = 0; c < 8; ++c) { const float v = lg[4 + gs * 8 + c] + a.in[11][gs * 8 + c];
                if (v > t0v) { t1v = t0v; t1i = t0i; t0v = v; t0i = c; } else if (v > t1v) { t1v = v; t1i = c; } }
            const float p0 = 1.f / (1.f + __expf(t1v - t0v));
            const int e0 = gs * 8 + t0i, e1 = gs * 8 + t1i;
            EID[2 * tok] = e0; EID[2 * tok + 1] = e1; GATE[2 * tok] = p0 * pg; GATE[2 * tok + 1] = (1.f - p0) * pg;
            atomicAdd((unsigned*)&lcnt[e0], 1u); atomicAdd((unsigned*)&lcnt[e1], 1u);
        }
        __syncthreads();
        if (tid < 32) CNT[vb * 32 + tid] = (int)lcnt[tid];
        __syncthreads();
    }
}
__device__ __forceinline__ void moe_assign_phase(Frame& F, const Args& a) {
    LAS unsigned char* L = F.lds + RING_OFF;
    LAS int* tot = (LAS int*)(L); LAS int* bef = (LAS int*)(L + 128); LAS int* base = (LAS int*)(L + 256); LAS unsigned* lcnt = (LAS unsigned*)(L + 384);
    const int* EID = (const int*)(a.ws + WS_EID); const float* GATE = (const float*)(a.ws + WS_GATE); const int* CNT = (const int*)(a.ws + WS_CNT);
    int* OFFS = (int*)(a.ws + WS_OFFS); int* DEST = (int*)(a.ws + WS_DEST); float* GPOS = (float*)(a.ws + WS_GPOS);
    int* TOKROW = (int*)(a.ws + WS_TOKROW);
    for (int vb = F.vcu; vb < 256; vb += F.G) {
        if (F.tid < 32) { int t = 0, b = 0; for (int k = 0; k < 256; ++k) { const int c = CNT[k * 32 + F.tid]; t += c; if (k < vb) b += c; } tot[F.tid] = t; bef[F.tid] = b; lcnt[F.tid] = 0u; }
        __syncthreads();
        if (F.tid < 32) { int off = 0; for (int e = 0; e < F.tid; ++e) off += (tot[e] + 255) & ~255; base[F.tid] = off + bef[F.tid];
            if (vb == 0) { OFFS[F.tid] = off; if (F.tid == 31) OFFS[32] = off + ((tot[31] + 255) & ~255); }
            if (vb == F.tid) { const int pend = off + ((tot[F.tid] + 255) & ~255); for (int p = off + tot[F.tid]; p < pend; ++p) { DEST[p] = -1; TOKROW[p] = 0; } } }
        __syncthreads();
        if (F.tid < 256) { const int item = vb * 256 + F.tid; const int e = EID[item];
            const int rank = (int)atomicAdd((unsigned*)&lcnt[e], 1u); const int pos = base[e] + rank;
            DEST[pos] = item; GPOS[pos] = GATE[item]; TOKROW[pos] = item >> 1; }
        __syncthreads();
        __syncthreads();
    }
}
struct MoeOrder {
    int nun, G, c; LAS const unsigned char* tileE;
    __device__ __forceinline__ bool next(int i, pg8::Unit& u) const { const int Lx = i * G + c; if (Lx >= nun) return false; const int mt = Lx >> 2; u.pm = mt; u.pn = (int)tileE[mt] * 4 + (Lx & 3); return true; }
    __device__ __forceinline__ void a_ready(const pg8::Unit&) const {}
    __device__ __forceinline__ void done(const pg8::Unit&) const {}
};
__device__ __forceinline__ int moe_tile_table(Frame& F, const Args& a) {
    const int* OFFS = (const int*)(a.ws + WS_OFFS);
    LAS unsigned char* tileE = F.lds + TILEE_OFF;
    const int ntm = OFFS[32] >> 8;
    if (F.tid < MOE_MAXTILES) { int e = 0; for (int k = 1; k < 32; ++k) if (OFFS[k] <= F.tid * 256) e = k; tileE[F.tid] = (unsigned char)e; }
    __syncthreads();
    return ntm;
}
struct EpiGateUp {
    static constexpr bool PERM = true, AFTER_DRAIN = false;
    bf16* HM;
    __device__ __forceinline__ void operator()(const f32x4 (&acc)[2][2][4][2], const pg8::Unit& u, int wr, int wc, int fr, int fq) const {
        const int row0 = u.pm * 256 + wr * 64 + fr, pnl = u.pn & 3;
#pragma unroll
        for (int ai = 0; ai < 2; ++ai)
#pragma unroll
            for (int m = 0; m < 4; ++m) { const int r = row0 + ai * 128 + m * 16;
#pragma unroll
                for (int bj = 0; bj < 2; ++bj) { const int c0 = pnl * 256 + bj * 128 + wc * 32 + 8 * fq; const f32x4 gt = acc[ai][bj][m][0], up = acc[ai][bj][m][1];
                    v2u w; w.x = pk2(silu_f(gt[0]) * up[0], silu_f(gt[1]) * up[1]); w.y = pk2(silu_f(gt[2]) * up[2], silu_f(gt[3]) * up[3]);
                    *(v2u*)(HM + (size_t)r * 512 + (c0 >> 1)) = w; } }
    }
};
struct EpiScatter {
    static constexpr bool PERM = true, AFTER_DRAIN = false;
    bf16* FF; const int* DEST; const float* GPOS;
    __device__ __forceinline__ void operator()(const f32x4 (&acc)[2][2][4][2], const pg8::Unit& u, int wr, int wc, int fr, int fq) const {
        const int row0 = u.pm * 256 + wr * 64 + fr, pnl = u.pn & 3;
#pragma unroll
        for (int ai = 0; ai < 2; ++ai)
#pragma unroll
            for (int m = 0; m < 4; ++m) { const int r = row0 + ai * 128 + m * 16; const int dest = DEST[r]; const float gt = GPOS[r];
                if (dest >= 0) {
#pragma unroll
                    for (int bj = 0; bj < 2; ++bj) { const int c0 = pnl * 256 + bj * 128 + wc * 32 + 8 * fq; const f32x4 v0 = acc[ai][bj][m][0] * gt, v1 = acc[ai][bj][m][1] * gt;
                        v4u w; w.x = pk2(v0[0], v0[1]); w.y = pk2(v0[2], v0[3]); w.z = pk2(v1[0], v1[1]); w.w = pk2(v1[2], v1[3]);
                        *(v4u*)(FF + (size_t)dest * 1024 + c0) = w; } } }
    }
};
typedef _Float16 f16x8 __attribute__((ext_vector_type(8)));
constexpr int SEL_SUB = 64;
constexpr int SEL_THR = MISC_OFF + 1024, SEL_RREM = SEL_THR + 256, SEL_CCNT = SEL_RREM + 256;
constexpr int SEL_MASKIMG = 0, SEL_CAND = 65536;
struct SelOps { f16x8 af[8]; f16x8 uf; f16x8 sf[4]; };
__device__ __forceinline__ unsigned pk_abs_h2(float a, float b) { return __builtin_bit_cast(unsigned, __builtin_amdgcn_cvt_pkrtz(__builtin_fabsf(a), __builtin_fabsf(b))); }
__device__ __forceinline__ f32x4 sel_group(const SelOps& O, const f16x8 bk) {
    const f32x4 z = {0.f, 0.f, 0.f, 0.f};
    f32x4 d[8];
#pragma unroll
    for (int rb = 0; rb < 8; ++rb) d[rb] = __builtin_amdgcn_mfma_f32_16x16x32_f16(O.af[rb], bk, z, 0, 0, 0);
    f32x4 acc = __builtin_amdgcn_mfma_f32_16x16x32_f16(O.uf, bk, z, 0, 0, 0);
#pragma unroll
    for (int j = 0; j < 4; ++j) {
        const v4u w = {pk_abs_h2(d[2 * j][0], d[2 * j][1]), pk_abs_h2(d[2 * j][2], d[2 * j][3]), pk_abs_h2(d[2 * j + 1][0], d[2 * j + 1][1]), pk_abs_h2(d[2 * j + 1][2], d[2 * j + 1][3])};
        acc = __builtin_amdgcn_mfma_f32_16x16x32_f16(O.sf[j], __builtin_bit_cast(f16x8, w), acc, 0, 0, 0);
    }
    return acc;
}
__device__ __forceinline__ int sel_bin(float s) { const float c = __builtin_amdgcn_fmed3f(s, -0.125f, 0.125f);
    return (int)__builtin_amdgcn_fmed3f(__builtin_fmaf(s, 64.f, __builtin_fmaf(c, 448.f, 512.f)), 0.f, 1023.f); }
__device__ __forceinline__ void sel_unit(Frame& F, const Args& a, int b, int c, BgConv& BG) {
    LAS unsigned char* L = F.lds + RING_OFF;
    LAS int* THR = (LAS int*)(F.lds + SEL_THR); LAS int* RREM = (LAS int*)(F.lds + SEL_RREM); LAS int* CCNT = (LAS int*)(F.lds + SEL_CCNT);
    const int tid = F.tid, lane = F.lane, w = F.wave, l15 = lane & 15, fq = lane >> 4, g = w & 3, kh = w >> 2;
    const unsigned short* IQ = (const unsigned short*)(a.ws + WS_IQ); const unsigned short* IK = (const unsigned short*)(a.ws + WS_IK); const float* IW = (const float*)(a.ws + WS_IW);
    const size_t qrow0 = (size_t)b * T + 64 * c + 16 * g, krow0 = (size_t)b * T;
    SelOps O;
#pragma unroll
    for (int rb = 0; rb < 8; ++rb) {
        const f16x8 raw = *(const f16x8*)(IQ + (qrow0 + 2 * rb + (l15 >> 3)) * 256 + (l15 & 7) * 32 + 8 * fq);
        O.af[rb] = raw * (_Float16)IW[(qrow0 + 2 * rb + (l15 >> 3)) * 8 + (l15 & 7)];
    }
    {
        const f32x4 w0 = *(const f32x4*)(IW + (qrow0 + l15) * 8), w1 = *(const f32x4*)(IW + (qrow0 + l15) * 8 + 4);
        const float wq[8] = {w0[0], w0[1], w0[2], w0[3], w1[0], w1[1], w1[2], w1[3]};
        float u[8] = {0.f, 0.f, 0.f, 0.f, 0.f, 0.f, 0.f, 0.f};
#pragma unroll
        for (int h = 0; h < 8; ++h) { const f16x8 fr = (*(const f16x8*)(IQ + (qrow0 + l15) * 256 + h * 32 + 8 * fq)) * (_Float16)wq[h];
#pragma unroll
            for (int e = 0; e < 8; ++e) u[e] += (float)fr[e]; }
#pragma unroll
        for (int e = 0; e < 8; ++e) O.uf[e] = (_Float16)(0.5f * u[e]);
#pragma unroll
        for (int j = 0; j < 4; ++j)
#pragma unroll
            for (int e = 0; e < 8; ++e) { const bool match = (l15 == 4 * j + 2 * (e >> 2) + (fq >> 1)); const float wv = (float)(_Float16)wq[4 * (fq & 1) + (e & 3)];
                O.sf[j][e] = match ? (wv < 0.f ? (_Float16)-0.5f : (_Float16)0.5f) : (_Float16)0.f; }
    }
    const unsigned short* ikl = IK + (krow0 + 32 * kh + l15) * 32 + 8 * fq;
    const unsigned hrow0 = (unsigned)((16 * g + 4 * fq) * 2048);
    if (c >= 4) {
#ifndef SEL_REP1
#define SEL_REP1 1
#endif
      for (int rep1 = 0; rep1 < SEL_REP1; ++rep1) {
        __syncthreads();
#pragma unroll 1
        for (int i = tid; i < RING_BYTES / 16; i += NWAVES * 64) *(LAS v4u*)(L + i * 16) = (v4u){0u, 0u, 0u, 0u};
        __syncthreads();
        f16x8 bf[2];
#pragma unroll
        for (int kk = 0; kk < 2; ++kk) bf[kk] = *(const f16x8*)(ikl + (size_t)(16 * kk) * 32);
        for (int t = 0; t <= c; ++t) {
            if ((t & 3) == 1) bg_issue(a, BG, lane); else if ((t & 3) == 3) bg_retire(a, BG, lane);
            f16x8 bn[2];
            const int tn = t < c ? t + 1 : t;
#pragma unroll
            for (int kk = 0; kk < 2; ++kk) bn[kk] = *(const f16x8*)(ikl + (size_t)(64 * tn + 16 * kk) * 32);
            f32x4 sc[2];
#pragma unroll
            for (int kk = 0; kk < 2; ++kk) sc[kk] = sel_group(O, bf[kk]);
#pragma unroll
            for (int kk = 0; kk < 2; ++kk)
#pragma unroll
                for (int r = 0; r < 4; ++r) { const unsigned bin = (unsigned)sel_bin(sc[kk][r]);
                    __hip_atomic_fetch_add((LAS unsigned*)(L + hrow0 + r * 2048 + ((bin >> 1) << 2)), 1u + (bin & 1u) * 65535u, __ATOMIC_RELAXED, __HIP_MEMORY_SCOPE_WORKGROUP); }
#pragma unroll
            for (int kk = 0; kk < 2; ++kk) bf[kk] = bn[kk];
        }
      }
        __syncthreads();
        for (int qq = 0; qq < 8; ++qq) {
            const int q = 8 * w + qq;
            const v4u h0 = *(LAS const v4u*)(L + q * 2048 + lane * 32), h1 = *(LAS const v4u*)(L + q * 2048 + lane * 32 + 16);
            const unsigned hw[8] = {h0.x, h0.y, h0.z, h0.w, h1.x, h1.y, h1.z, h1.w};
            int tot = 0;
#pragma unroll
            for (int k = 0; k < 8; ++k) tot += (int)(hw[k] & 0xffffu) + (int)(hw[k] >> 16);
            int inc = tot;
#pragma unroll
            for (int o = 1; o < 64; o <<= 1) { const int v = __shfl_up(inc, o); if (lane >= o) inc += v; }
            const int all = __shfl(inc, 63);
            const int above = all - inc;
            if (above < 256 && above + tot >= 256) {
                int cum = above, B = 16 * lane, r = 1; bool done = false;
#pragma unroll
                for (int k = 7; k >= 0; --k) {
                    const int chi = (int)(hw[k] >> 16), clo = (int)(hw[k] & 0xffffu);
                    if (!done) { if (cum + chi >= 256) { B = 16 * lane + 2 * k + 1; r = 256 - cum; done = true; } else cum += chi; }
                    if (!done) { if (cum + clo >= 256) { B = 16 * lane + 2 * k; r = 256 - cum; done = true; } else cum += clo; }
                }
                THR[q] = B; RREM[q] = r;
            }
        }
    } else {
        if (tid < 64) { THR[tid] = -1; RREM[tid] = 0; }
    }
    __syncthreads();
#ifndef SEL_REP2
#define SEL_REP2 1
#endif
  for (int rep2 = 0; rep2 < SEL_REP2; ++rep2) {
    __syncthreads();
#pragma unroll 1
    for (int i = tid; i < RING_BYTES / 16; i += NWAVES * 64) *(LAS v4u*)(L + i * 16) = (v4u){0u, 0u, 0u, 0u};
    if (tid < 128) CCNT[tid] = 0;
    __syncthreads();
    {
        int tb[4];
#pragma unroll
        for (int r = 0; r < 4; ++r) tb[r] = THR[16 * g + 4 * fq + r];
        const unsigned mrow = (unsigned)(SEL_MASKIMG + (16 * g + l15) * 1024 + kh * 4);
        f16x8 bf[2];
#pragma unroll
        for (int kk = 0; kk < 2; ++kk) bf[kk] = *(const f16x8*)(ikl + (size_t)(16 * kk) * 32);
        for (int t = 0; t <= c; ++t) {
            if ((t & 3) == 1) bg_issue(a, BG, lane); else if ((t & 3) == 3) bg_retire(a, BG, lane);
            f16x8 bn[2];
            const int tn = t < c ? t + 1 : t;
#pragma unroll
            for (int kk = 0; kk < 2; ++kk) bn[kk] = *(const f16x8*)(ikl + (size_t)(64 * tn + 16 * kk) * 32);
            f32x4 sc[2];
#pragma unroll
            for (int kk = 0; kk < 2; ++kk) sc[kk] = sel_group(O, bf[kk]);
            int bins[2][4]; unsigned long long sm[2][4], cm[2][4]; unsigned long long anyc = 0ull;
#pragma unroll
            for (int kk = 0; kk < 2; ++kk)
#pragma unroll
                for (int r = 0; r < 4; ++r) { bins[kk][r] = sel_bin(sc[kk][r]); sm[kk][r] = __ballot(bins[kk][r] > tb[r]); cm[kk][r] = __ballot(bins[kk][r] == tb[r]); anyc |= cm[kk][r]; }
            unsigned mword = 0u;
#pragma unroll
            for (int r = 0; r < 4; ++r)
#pragma unroll
                for (int f = 0; f < 4; ++f) { const unsigned wd = ((unsigned)(sm[0][r] >> (16 * f)) & 0xffffu) | (((unsigned)(sm[1][r] >> (16 * f)) & 0xffffu) << 16);
                    asm("s_nop 4\n\tv_writelane_b32 %0, %1, %2" : "+v"(mword) : "s"(wd), "n"(4 * f + r)); }
            if (lane < 16) *(LAS unsigned*)(L + mrow + t * 8) = mword;
            if (anyc) {
#pragma unroll
                for (int kk = 0; kk < 2; ++kk)
#pragma unroll
                    for (int r = 0; r < 4; ++r) if (cm[kk][r]) {
                        const bool cand = (bins[kk][r] == tb[r]);
                        const unsigned mylo = (unsigned)(cm[kk][r] >> (16 * fq)) & 0xffffu;
                        const int sub = (16 * g + 4 * fq + r) * 2 + kh;
                        const int cnt0 = CCNT[sub];
                        const int slot = cnt0 + __popc(mylo & ((1u << l15) - 1u));
                        if (cand && slot < SEL_SUB) *(LAS v2u*)(L + SEL_CAND + (sub * SEL_SUB + slot) * 8) = (v2u){__float_as_uint(sc[kk][r]), (unsigned)(64 * t + 32 * kh + 16 * kk + l15)};
                        if (l15 == 0) CCNT[sub] = cnt0 + __popc(mylo); }
            }
#pragma unroll
            for (int kk = 0; kk < 2; ++kk) bf[kk] = bn[kk];
        }
    }
  }
    __syncthreads();
    for (int qq = 0; qq < 8; ++qq) {
        const int q = 8 * w + qq; const int n0 = min(CCNT[2 * q], SEL_SUB), n1 = min(CCNT[2 * q + 1], SEL_SUB), r = RREM[q];
        if (r > 0 && n0 + n1 > 0) {
            const v2u c0 = *(LAS const v2u*)(L + SEL_CAND + ((2 * q) * SEL_SUB + lane) * 8), c1 = *(LAS const v2u*)(L + SEL_CAND + ((2 * q + 1) * SEL_SUB + lane) * 8);
            const unsigned k0 = c0.y, k1 = c1.y; const float s0 = __uint_as_float(c0.x), s1 = __uint_as_float(c1.x);
            int rank0 = 0, rank1 = 0;
            for (int j = 0; j < n0 + n1; ++j) { const int jj = j < n0 ? j : SEL_SUB + (j - n0);
                const v2u cj = *(LAS const v2u*)(L + SEL_CAND + ((2 * q) * SEL_SUB + jj) * 8); const float sj = __uint_as_float(cj.x); const unsigned kj = cj.y;
                rank0 += (sj > s0 || (sj == s0 && kj < k0)) ? 1 : 0; rank1 += (sj > s1 || (sj == s1 && kj < k1)) ? 1 : 0; }
            if (lane < n0 && rank0 < r) __hip_atomic_fetch_or((LAS unsigned*)(L + SEL_MASKIMG + q * 1024 + (k0 >> 5) * 4), 1u << (k0 & 31), __ATOMIC_RELAXED, __HIP_MEMORY_SCOPE_WORKGROUP);
            if (lane < n1 && rank1 < r) __hip_atomic_fetch_or((LAS unsigned*)(L + SEL_MASKIMG + q * 1024 + (k1 >> 5) * 4), 1u << (k1 & 31), __ATOMIC_RELAXED, __HIP_MEMORY_SCOPE_WORKGROUP);
        }
    }
    __syncthreads();
    { unsigned long long* MK = (unsigned long long*)(a.ws + WS_MASK);
      const int ntw = (c | 3) + 1;
#pragma unroll 1
      for (int i = tid; i < ntw * 64; i += NWAVES * 64) { const int t = i >> 6, q = i & 63;
          MK[((size_t)b * NCHUNK + t) * T + 64 * c + q] = *(LAS const unsigned long long*)(L + SEL_MASKIMG + q * 1024 + t * 8); } }
    __syncthreads();
}
__device__ __forceinline__ void sel_phase(Frame& F, const Args& a) {
    BgConv BG; BG.next = F.vcu * NWAVES + F.wave; BG.stride = F.G * NWAVES; BG.cur = -1;
    for (int v = F.vcu; v < 256; v += F.G) { const int b = v >> 6, p = v & 63; sel_unit(F, a, b, p, BG); sel_unit(F, a, b, 127 - p, BG); }
    while (BG.cur >= 0 || BG.next < BG_TASKS) { bg_retire(a, BG, F.lane); bg_issue(a, BG, F.lane); }
}
namespace attn_body {
using bf16=__hip_bfloat16;
using bf16x8=__attribute__((ext_vector_type(8)))short;
using s16x4=__attribute__((ext_vector_type(4)))short;
using f32x16=__attribute__((ext_vector_type(16)))float;
using u32x4=__attribute__((ext_vector_type(4)))unsigned;
constexpr int BATCH=4,NHEAD=8,SEQ=8192,D=64,DM=NHEAD*D,OPITCH=1024;
constexpr int NW=8,QBLK=32,QB=QBLK*NW,KVBLK=64,NQB=SEQ/QB;
constexpr int ATTN_PITCH=DM, ATTN_UNIT_ROWS=QB;
__device__ __forceinline__ int crow(int r,int hi){return (r&3)+8*(r>>2)+4*hi;}
#define SBAR() __builtin_amdgcn_sched_barrier(0)
constexpr int NSLOT=3, SLOTB=8192;
constexpr int LDS_K=0, LDS_V=NSLOT*SLOTB, LDS_WS=2*NSLOT*SLOTB, LDS_OST=LDS_WS+NW*64*4, LDS_MSK=LDS_OST+NW*4096, LDS_BYTES=LDS_MSK+NSLOT*2048;
constexpr float C2=0.125f*1.4426950408889634f;
__device__ __forceinline__ void glds16(const void*gsrc,unsigned lds_dst){unsigned keep;
  asm volatile("s_mov_b32 %0, m0\n\ts_mov_b32 m0, %2\n\ts_nop 0\n\tglobal_load_lds_dwordx4 %1, off\n\ts_mov_b32 m0, %0":"=&s"(keep):"v"(gsrc),"s"(lds_dst):"memory");}
__device__ __forceinline__ void glds4(const void*gsrc,unsigned lds_dst){unsigned keep;
  asm volatile("s_mov_b32 %0, m0\n\ts_mov_b32 m0, %2\n\ts_nop 0\n\tglobal_load_lds_dword %1, off\n\ts_mov_b32 m0, %0":"=&s"(keep):"v"(gsrc),"s"(lds_dst):"memory");}
__device__ __forceinline__ float max3f(float a,float b,float c){float r;asm("v_max3_f32 %0, %1, %2, %3":"=v"(r):"v"(a),"v"(b),"v"(c));return r;}
__device__ __forceinline__ float max2f(float a,float b){float r;asm("v_max_f32_e32 %0, %1, %2":"=v"(r):"v"(a),"v"(b));return r;}
__device__ __forceinline__ float fadd_s(float a,float b){float r;asm("v_add_f32_e32 %0, %1, %2":"=v"(r):"v"(a),"v"(b));return r;}
__device__ __forceinline__ float fsub_s(float a,float b){float r;asm("v_sub_f32_e32 %0, %1, %2":"=v"(r):"v"(a),"v"(b));return r;}
typedef float f32x2_t __attribute__((ext_vector_type(2))); typedef __bf16 bf16x2_t __attribute__((ext_vector_type(2)));
__device__ __forceinline__ unsigned cvtpk_s(float lo,float hi){f32x2_t v={lo,hi};bf16x2_t b=__builtin_convertvector(v,bf16x2_t);return __builtin_bit_cast(unsigned,b);}
#define WAIT_BAR(N) asm volatile("s_waitcnt vmcnt(" #N ") lgkmcnt(0)\n\ts_barrier":::"memory")

__device__ __forceinline__ void qkt(f32x16&p0,f32x16&p1,const char*Kslot,const bf16x8*qr,const f32x16&negm,int r32,int hi){
  const char*kb=Kslot+hi*1024+r32*16;
  #pragma unroll
  for(int d0=0;d0<4;++d0){
    const bf16x8 b0=*reinterpret_cast<const bf16x8*>(kb+d0*2048);
    const bf16x8 b1=*reinterpret_cast<const bf16x8*>(kb+d0*2048+512);
    if(d0==0){p0=__builtin_amdgcn_mfma_f32_32x32x16_bf16(b0,qr[0],negm,0,0,0);p1=__builtin_amdgcn_mfma_f32_32x32x16_bf16(b1,qr[0],negm,0,0,0);}
    else{p0=__builtin_amdgcn_mfma_f32_32x32x16_bf16(b0,qr[d0],p0,0,0,0);p1=__builtin_amdgcn_mfma_f32_32x32x16_bf16(b1,qr[d0],p1,0,0,0);}}
}
typedef __attribute__((address_space(3))) const char* lds_cptr;
typedef short v4i16_t __attribute__((ext_vector_type(4)));
__device__ __forceinline__ void kload8(bf16x8*kf,lds_cptr kp){
  kf[0]=*(const __attribute__((address_space(3))) bf16x8*)(kp);      kf[1]=*(const __attribute__((address_space(3))) bf16x8*)(kp+512);
  kf[2]=*(const __attribute__((address_space(3))) bf16x8*)(kp+2048); kf[3]=*(const __attribute__((address_space(3))) bf16x8*)(kp+2560);
  kf[4]=*(const __attribute__((address_space(3))) bf16x8*)(kp+4096); kf[5]=*(const __attribute__((address_space(3))) bf16x8*)(kp+4608);
  kf[6]=*(const __attribute__((address_space(3))) bf16x8*)(kp+6144); kf[7]=*(const __attribute__((address_space(3))) bf16x8*)(kp+6656);
}
__device__ __forceinline__ void kload2(bf16x8*kf,lds_cptr kp,int j){ kf[2*j]=*(const __attribute__((address_space(3))) bf16x8*)(kp+j*2048); kf[2*j+1]=*(const __attribute__((address_space(3))) bf16x8*)(kp+j*2048+512); }
__device__ __forceinline__ s16x4 vtr(lds_cptr p){ return __builtin_bit_cast(s16x4,__builtin_amdgcn_ds_read_tr16_b64_v4i16((__attribute__((address_space(3))) v4i16_t*)p)); }
__device__ __forceinline__ float rowmax(const f32x16&p0,const f32x16&p1){
  float a=max3f(p0[0],p0[1],p1[0]),b=max3f(p0[2],p0[3],p1[1]);a=max3f(a,p1[2],p1[3]);
  #pragma unroll
  for(int r=4;r<16;r+=4){a=max3f(a,p0[r],p0[r+1]);b=max3f(b,p0[r+2],p0[r+3]);a=max3f(a,p1[r],p1[r+1]);b=max3f(b,p1[r+2],p1[r+3]);}
  const float m=max2f(a,b);
  auto rr=__builtin_amdgcn_permlane32_swap(__float_as_uint(m),__float_as_uint(m),false,false);
  return max2f(__uint_as_float(rr[0]),__uint_as_float(rr[1]));
}
__device__ __forceinline__ void pv(f32x16*o,int vb,bf16x8 pa0,bf16x8 pa1,bf16x8 pa2,bf16x8 pa3){
  #pragma unroll
  for(int d0=0;d0<2;++d0){s16x4 lo[4],hi[4];
    #pragma unroll
    for(int ks=0;ks<4;++ks){
      asm volatile("ds_read_b64_tr_b16 %0,%1 offset:%c2":"=&v"(lo[ks]):"v"(vb),"i"(d0*4096+ks*1024):"memory");
      asm volatile("ds_read_b64_tr_b16 %0,%1 offset:%c2":"=&v"(hi[ks]):"v"(vb),"i"(d0*4096+ks*1024+512):"memory");}
    asm volatile("s_waitcnt lgkmcnt(0)":::"memory");SBAR();
    #define PK(k) (bf16x8){lo[k][0],lo[k][1],lo[k][2],lo[k][3],hi[k][0],hi[k][1],hi[k][2],hi[k][3]}
    o[d0]=__builtin_amdgcn_mfma_f32_32x32x16_bf16(pa0,PK(0),o[d0],0,0,0);
    o[d0]=__builtin_amdgcn_mfma_f32_32x32x16_bf16(pa1,PK(1),o[d0],0,0,0);
    o[d0]=__builtin_amdgcn_mfma_f32_32x32x16_bf16(pa2,PK(2),o[d0],0,0,0);
    o[d0]=__builtin_amdgcn_mfma_f32_32x32x16_bf16(pa3,PK(3),o[d0],0,0,0);
    #undef PK
  }
}

#ifndef ATTN_STORE16
#define ATTN_STORE16(p,v) (*(u32x4*)(p)=(v))
#endif
template<int THRL> __device__ __forceinline__ void attn_unit(int b,int h,int qb,const bf16*Q,const bf16*__restrict__ K,const bf16*__restrict__ V,bf16*O,const unsigned*MSK,char*shm){
  const int tid=threadIdx.x,lane=tid&63,r32=lane&31,hi=lane>>5; const int wid=__builtin_amdgcn_readfirstlane(tid>>6);
  const long rowbase=(long)b*SEQ; const int q0=qb*QB;
  const bf16*Qw=Q+(rowbase+q0+wid*QBLK)*DM+h*D;
  const bf16*Kh=K+rowbase*DM+h*D,*Vh=V+rowbase*DM+h*D;
  const unsigned lds0=(unsigned)(uintptr_t)shm;
  float*wsf=(float*)(shm+LDS_WS)+wid*64;
  const bf16*ksrc=Kh+(long)lane*DM+wid*8;
  const bf16*vsrc=Vh+(long)(16*(wid&3)+(lane>>2))*DM+(wid>>2)*32+(lane&3)*8;
  const unsigned kdst=lds0+LDS_K+wid*1024, vdst=lds0+LDS_V+wid*1024, mdst=lds0+LDS_MSK+wid*256;
  const unsigned*msrc=MSK+(((size_t)b*(SEQ/KVBLK))*SEQ+q0+wid*QBLK)*2+lane;
  typedef __attribute__((address_space(3))) const unsigned long long* lds_u64p;
  #define DMA_K(t,slot) glds16(ksrc+(long)(t)*KVBLK*DM,(unsigned)__builtin_amdgcn_readfirstlane(kdst+(slot)))
  #define DMA_V(t,slot) do{ glds16(vsrc+(long)(t)*KVBLK*DM,(unsigned)__builtin_amdgcn_readfirstlane(vdst+(slot))); glds4(msrc+(size_t)(t)*SEQ*2,(unsigned)__builtin_amdgcn_readfirstlane(mdst+((slot)>>2))); }while(0)
  const int vb0=(int)(lds0+LDS_V)+((lane>>4)&1)*32+(lane&3)*8+(4*hi+((lane&15)>>2))*64;
  const char*Kbase=shm+LDS_K; bf16x8 kf[8];
  const lds_cptr shm3=(lds_cptr)shm; const lds_cptr kp0=shm3+LDS_K+hi*1024+r32*16; const lds_cptr vp0=shm3+LDS_V+((lane>>4)&1)*32+(lane&3)*8+(4*hi+((lane&15)>>2))*64;
  const lds_cptr mp0=shm3+LDS_MSK+wid*256+r32*8;
  const int NT=(q0+QB)/KVBLK;
  DMA_K(0,0);DMA_V(0,0);DMA_K(1,SLOTB);
  bf16x8 qr[4];
  #pragma unroll
  for(int d0=0;d0<4;++d0)qr[d0]=*reinterpret_cast<const bf16x8*>(&Qw[(long)r32*DM+d0*16+hi*8]);
  float mhat=0.f,l_reg=0.f;f32x16 o[2];o[0]=f32x16{};o[1]=f32x16{};f32x16 negm=f32x16{};asm volatile("":"+v"(negm));
  const int qrel=wid*QBLK+r32;
  bool resc=false;
  #define START(P0,P1) do{ const float rm=rowmax(P0,P1); resc=false; \
    { const float dl=rm; mhat=fadd_s(mhat,dl); \
      _Pragma("unroll") for(int r=0;r<16;++r){P0[r]=fsub_s(P0[r],dl);P1[r]=fsub_s(P1[r],dl);} \
      _Pragma("unroll") for(int r=0;r<16;++r)negm[r]=-mhat; asm volatile("":"+v"(negm)); } \
    _Pragma("unroll") for(int r=0;r<16;++r)P0[r]=__builtin_amdgcn_exp2f(P0[r]); }while(0)
  #define RESC() do{ if(resc){ asm volatile("s_waitcnt lgkmcnt(0)":::"memory"); \
      _Pragma("unroll") for(int d_=0;d_<2;++d_) _Pragma("unroll") for(int r=0;r<16;++r)o[d_][r]*=wsf[crow(r,hi)]; } }while(0)
  f32x16 pA0,pA1,pB0,pB1;
  int sl_prev=0,sl_cur=0,sl_next=SLOTB;
  #define ROT() do{sl_prev=sl_cur;sl_cur=sl_next;sl_next=(sl_next==(NSLOT-1)*SLOTB)?0:sl_next+SLOTB;}while(0)
  DMA_K(2,2*SLOTB);
  WAIT_BAR(4);
  qkt(pA0,pA1,Kbase,qr,negm,r32,hi);asm volatile("s_nop 15\n\ts_nop 7":"+v"(pA0),"+v"(pA1));
  START(pA0,pA1);
  _Pragma("unroll") for(int r=0;r<16;++r)pA1[r]=__builtin_amdgcn_exp2f(pA1[r]);
  WAIT_BAR(0);
  DMA_K(3,0);DMA_V(1,SLOTB);
  ROT();
  kload8(kf,kp0+sl_cur);
  WAIT_BAR(3);
  s16x4 vlo[8],vhi[8]; u32x4 pw0,pw1,pw2,pw3;
  #define PKW(P,B) cvtpk_s(P[B],P[B+1])
  #define PAF(k) __builtin_bit_cast(bf16x8,pw##k)
  #define VFR(i) (bf16x8){vlo[i][0],vlo[i][1],vlo[i][2],vlo[i][3],vhi[i][0],vhi[i][1],vhi[i][2],vhi[i][3]}
  #define PIN(x) asm volatile("":"+v"(x))
  #define MX3(a,b,c) __builtin_fmaxf(__builtin_fmaxf((a),(b)),(c))
  #define MKB(P,r,W) do{ const float pv_=P[r]; P[r]=__uint_as_float(__float_as_uint(pv_)&(unsigned)__builtin_amdgcn_sbfe((int)(W),((r)&3)+8*((r)>>2),1)); }while(0)
  #define GAPA(MF,M0,M1,M2,M3,A0,A1,A2,A3,W0,W1,PW) do{ MF; M0; M1; M2; M3; sacc+=A0; sacc+=A1; sacc+=A2; sacc+=A3; PIN(sacc); W0; W1; PIN(PW); SBAR(); }while(0)
  #define EX(v) __builtin_amdgcn_exp2f(v)
  #define GAPB(MF,X,B) do{ MF; X[B]=EX(X[B]); X[B+1]=EX(X[B+1]); X[B+2]=EX(X[B+2]); X[B+3]=EX(X[B+3]); PIN(X); SBAR(); }while(0)
  #define VRD(i) do{ vlo[i]=vtr(vp_+(((i)>>2)*4096+((i)&3)*1024)); vhi[i]=vtr(vp_+(((i)>>2)*4096+((i)&3)*1024+512)); }while(0)
  #define KRD(G,j) do{ if(G){ kload2(kf,kp0+sl_next,j); SBAR(); } }while(0)
  #define STEP(C0,C1,P0,P1,t,GK,GV,GL) do{ SBAR(); \
    const lds_cptr vp_=vp0+sl_prev; \
    const unsigned long long mw_=*(lds_u64p)(mp0+(sl_prev>>2)); const unsigned mlo_=(unsigned)mw_>>(4*hi), mhi_=(unsigned)(mw_>>32)>>(4*hi); \
    VRD(0); SBAR(); MKB(P0,0,mlo_); MKB(P0,1,mlo_); float sacc=(P0[0]+P0[1]); \
    GAPA(C0=__builtin_amdgcn_mfma_f32_32x32x16_bf16(kf[0],qr[0],negm,0,0,0), MKB(P0,2,mlo_),MKB(P0,3,mlo_),MKB(P0,4,mlo_),MKB(P0,5,mlo_), P0[2],P0[3],P0[4],P0[5],     pw0[0]=PKW(P0,0), pw0[1]=PKW(P0,2), pw0); \
    VRD(4); SBAR(); GAPA(C1=__builtin_amdgcn_mfma_f32_32x32x16_bf16(kf[1],qr[0],negm,0,0,0), MKB(P0,6,mlo_),MKB(P0,7,mlo_),MKB(P0,8,mlo_),MKB(P0,9,mlo_), P0[6],P0[7],P0[8],P0[9],     pw0[2]=PKW(P0,4), pw0[3]=PKW(P0,6), pw0); \
    VRD(1); SBAR(); GAPA(C0=__builtin_amdgcn_mfma_f32_32x32x16_bf16(kf[2],qr[1],C0,0,0,0),   MKB(P0,10,mlo_),MKB(P0,11,mlo_),MKB(P0,12,mlo_),MKB(P0,13,mlo_), P0[10],P0[11],P0[12],P0[13], pw1[0]=PKW(P0,8), pw1[1]=PKW(P0,10), pw1); \
    VRD(5); SBAR(); GAPA(C1=__builtin_amdgcn_mfma_f32_32x32x16_bf16(kf[3],qr[1],C1,0,0,0),   MKB(P0,14,mlo_),MKB(P0,15,mlo_),MKB(P1,0,mhi_),MKB(P1,1,mhi_), P0[14],P0[15],P1[0],P1[1],   pw1[2]=PKW(P0,12),pw1[3]=PKW(P0,14), pw1); \
    VRD(2); SBAR(); GAPA(C0=__builtin_amdgcn_mfma_f32_32x32x16_bf16(kf[4],qr[2],C0,0,0,0),   MKB(P1,2,mhi_),MKB(P1,3,mhi_),MKB(P1,4,mhi_),MKB(P1,5,mhi_), P1[2],P1[3],P1[4],P1[5],     pw2[0]=PKW(P1,0), pw2[1]=PKW(P1,2), pw2); \
    VRD(6); SBAR(); GAPA(C1=__builtin_amdgcn_mfma_f32_32x32x16_bf16(kf[5],qr[2],C1,0,0,0),   MKB(P1,6,mhi_),MKB(P1,7,mhi_),MKB(P1,8,mhi_),MKB(P1,9,mhi_), P1[6],P1[7],P1[8],P1[9],     pw2[2]=PKW(P1,4), pw2[3]=PKW(P1,6), pw2); \
    VRD(3); SBAR(); GAPA(C0=__builtin_amdgcn_mfma_f32_32x32x16_bf16(kf[6],qr[3],C0,0,0,0),   MKB(P1,10,mhi_),MKB(P1,11,mhi_),MKB(P1,12,mhi_),MKB(P1,13,mhi_), P1[10],P1[11],P1[12],P1[13], pw3[0]=PKW(P1,8), pw3[1]=PKW(P1,10), pw3); \
    VRD(7); SBAR(); GAPA(C1=__builtin_amdgcn_mfma_f32_32x32x16_bf16(kf[7],qr[3],C1,0,0,0),   MKB(P1,14,mhi_),MKB(P1,15,mhi_),do{}while(0),do{}while(0), P1[14],P1[15],0.f,0.f,       pw3[2]=PKW(P1,12),pw3[3]=PKW(P1,14), pw3); \
    l_reg+=sacc; \
    if(GK){DMA_K((t)+3,sl_cur);} if(GV){DMA_V((t)+1,sl_next);} \
    { float a=MX3(C0[0],C0[1],C1[0]),b=MX3(C0[2],C0[3],C1[1]); a=MX3(a,C1[2],C1[3]); \
      _Pragma("unroll") for(int r=4;r<16;r+=4){a=MX3(a,C0[r],C0[r+1]);b=MX3(b,C0[r+2],C0[r+3]);a=MX3(a,C1[r],C1[r+1]);b=MX3(b,C1[r+2],C1[r+3]);} \
      float rm=__builtin_fmaxf(a,b); { auto rr=__builtin_amdgcn_permlane32_swap(__float_as_uint(rm),__float_as_uint(rm),false,false); rm=__builtin_fmaxf(__uint_as_float(rr[0]),__uint_as_float(rr[1])); } \
      resc=false; \
      if(__builtin_expect(__any(rm>(float)THRL),0)){ const float dl=__builtin_fmaxf(rm,0.f); mhat+=dl; \
        _Pragma("unroll") for(int r=0;r<16;++r){C0[r]-=dl;C1[r]-=dl;} \
        _Pragma("unroll") for(int r=0;r<16;++r)negm[r]=-mhat; asm volatile("":"+v"(negm)); \
        const float f=__builtin_amdgcn_exp2f(-dl); l_reg*=f; if(hi==0)wsf[r32]=f; resc=true; } } \
    SBAR(); \
    GAPB(o[0]=__builtin_amdgcn_mfma_f32_32x32x16_bf16(PAF(0),VFR(0),o[0],0,0,0), C0,0); \
    GAPB(o[1]=__builtin_amdgcn_mfma_f32_32x32x16_bf16(PAF(0),VFR(4),o[1],0,0,0), C0,4); \
    KRD(GL,0); GAPB(o[0]=__builtin_amdgcn_mfma_f32_32x32x16_bf16(PAF(1),VFR(1),o[0],0,0,0), C0,8); \
    KRD(GL,1); GAPB(o[1]=__builtin_amdgcn_mfma_f32_32x32x16_bf16(PAF(1),VFR(5),o[1],0,0,0), C0,12); \
    KRD(GL,2); GAPB(o[0]=__builtin_amdgcn_mfma_f32_32x32x16_bf16(PAF(2),VFR(2),o[0],0,0,0), C1,0); \
    KRD(GL,3); GAPB(o[1]=__builtin_amdgcn_mfma_f32_32x32x16_bf16(PAF(2),VFR(6),o[1],0,0,0), C1,4); \
    GAPB(o[0]=__builtin_amdgcn_mfma_f32_32x32x16_bf16(PAF(3),VFR(3),o[0],0,0,0), C1,8); \
    GAPB(o[1]=__builtin_amdgcn_mfma_f32_32x32x16_bf16(PAF(3),VFR(7),o[1],0,0,0), C1,12); \
    }while(0)
  int t=1;
  for(;t+5<NT;t+=2){
    STEP(pB0,pB1,pA0,pA1,t,true,true,true);     WAIT_BAR(3); RESC(); ROT();
    STEP(pA0,pA1,pB0,pB1,t+1,true,true,true);   WAIT_BAR(3); RESC(); ROT();
  }
  #define ENDW(tt) do{ if((tt)+3<NT){WAIT_BAR(3);} else if((tt)+2<NT){WAIT_BAR(2);} else {WAIT_BAR(0);} }while(0)
  for(;t+1<NT;t+=2){
    STEP(pB0,pB1,pA0,pA1,t,(t+3<NT),(t+1<NT),(t+1<NT));       ENDW(t);   RESC(); ROT();
    STEP(pA0,pA1,pB0,pB1,t+1,(t+4<NT),(t+2<NT),(t+2<NT));     ENDW(t+1); RESC(); ROT();
  }
  STEP(pB0,pB1,pA0,pA1,NT-1,false,false,false); RESC();
  { const unsigned long long mwd=*(lds_u64p)(mp0+(sl_cur>>2)); const unsigned mlo_=(unsigned)mwd>>(4*hi), mhi_=(unsigned)(mwd>>32)>>(4*hi);
    _Pragma("unroll") for(int r=0;r<16;++r){ MKB(pB0,r,mlo_); MKB(pB1,r,mhi_); }
    float sacc=pB0[0]+pB0[1]; _Pragma("unroll") for(int r=2;r<16;++r)sacc+=pB0[r]; _Pragma("unroll") for(int r=0;r<16;++r)sacc+=pB1[r]; l_reg+=sacc;
    pw0=(u32x4){PKW(pB0,0),PKW(pB0,2),PKW(pB0,4),PKW(pB0,6)};pw1=(u32x4){PKW(pB0,8),PKW(pB0,10),PKW(pB0,12),PKW(pB0,14)};pw2=(u32x4){PKW(pB1,0),PKW(pB1,2),PKW(pB1,4),PKW(pB1,6)};pw3=(u32x4){PKW(pB1,8),PKW(pB1,10),PKW(pB1,12),PKW(pB1,14)};
    SBAR(); pv(o,vb0+sl_cur,PAF(0),PAF(1),PAF(2),PAF(3)); }
  #undef PKW
  #undef PAF
  #undef VFR
  #undef PIN
  #undef MX3
  #undef GAPA
  #undef MKB
  #undef GAPB
  #undef EX
  #undef VRD
  #undef KRD
  #undef STEP
  #undef ENDW
  {auto rr=__builtin_amdgcn_permlane32_swap(__float_as_uint(l_reg),__float_as_uint(l_reg),false,false);l_reg=__uint_as_float(rr[0])+__uint_as_float(rr[1]);}
  if(hi==0)wsf[32+r32]=l_reg;asm volatile("s_waitcnt lgkmcnt(0)":::"memory");
  float rli[16];
  #pragma unroll
  for(int r=0;r<16;++r)rli[r]=__builtin_amdgcn_rcpf(wsf[32+crow(r,hi)]);
  bf16*Ow=O+(rowbase+q0+wid*QBLK)*OPITCH+h*D;
  { bf16*stg=(bf16*)(shm+LDS_OST)+wid*2048;
    #pragma unroll
    for(int r=0;r<16;++r){const int orow=crow(r,hi);
      #pragma unroll
      for(int d0=0;d0<2;++d0)stg[orow*64+d0*32+r32]=__float2bfloat16(o[d0][r]*rli[r]);}
    asm volatile("s_waitcnt lgkmcnt(0)":::"memory");
    #pragma unroll
    for(int i=0;i<4;++i){const int row=i*8+(lane>>3),ch=lane&7; const u32x4 v=*(const u32x4*)(stg+row*64+ch*8); ATTN_STORE16(Ow+(long)row*OPITCH+ch*8,v);} }
  asm volatile("s_waitcnt lgkmcnt(0)\n\ts_barrier":::"memory");
  #undef DMA_K
  #undef DMA_V
  #undef START
  #undef RESC
  #undef ROT
}
constexpr int ATTN_LDS_BYTES=LDS_BYTES;
struct AttnTensors { const bf16* Q; const bf16* K; const bf16* V; bf16* O; const unsigned* MSK; };
struct AttnUnit { int bh; int qb; };
struct StaticOrder {
  int vcu;
  __device__ __forceinline__ explicit StaticOrder(int grid,int block):vcu((block%8)*(grid/8)+block/8){}
  __device__ __forceinline__ bool next(int i,AttnUnit&u)const{ if(i>=4)return false; const int s=vcu&7; u.bh=vcu>>3; u.qb=(i==0)?s:(i==1)?15-s:(i==2)?16+s:31-s; return true; }
  __device__ __forceinline__ void a_ready(const AttnUnit&)const{}
  __device__ __forceinline__ void done(const AttnUnit&)const{}
};
template<class Sched,int THRL=8> __device__ __forceinline__ void attn_phase(char*lds,const AttnTensors&T,const Sched&S){
  AttnUnit u;
  for(int i=0;S.next(i,u);++i){ S.a_ready(u); attn_unit<THRL>(u.bh/NHEAD,u.bh%NHEAD,u.qb,T.Q,T.K,T.V,T.O,T.MSK,lds); S.done(u); }
}
#undef SBAR
#undef WAIT_BAR
}
constexpr int N_PHASES = 12;
#ifndef REPEAT_PH
#define REPEAT_PH -1
#endif
#define RUNPH(k, ...) do { __VA_ARGS__; if (REPEAT_PH == (k)) { GRID_BAR(); __VA_ARGS__; } } while (0)
#ifdef TIMING_A
#define STAMP(k) do { if (blockIdx.x == 0 && F.tid == 0) __hip_atomic_store(F.ctl + 16 + 2 * (k), (unsigned)__builtin_amdgcn_s_memrealtime(), RLX_AGENT); } while (0)
#else
#define STAMP(k) do {} while (0)
#endif
__global__ void __launch_bounds__(NWAVES * 64, 2) mk_fwd(Args args) {
    extern __shared__ __attribute__((aligned(16))) unsigned char lds[];
    Frame F;
    F.lds = (LAS unsigned char*)lds;
    F.MISC = (volatile LAS unsigned*)(F.lds + MISC_OFF);
    F.tid = threadIdx.x; F.lane = F.tid & 63; F.wave = __builtin_amdgcn_readfirstlane(F.tid >> 6);
    F.G = gridDim.x; { const int bx = blockIdx.x; F.vcu = (F.G % 8 == 0) ? (bx % 8) * (F.G / 8) + bx / 8 : bx; }
    unsigned char* ws = args.ws;
    F.ctl = (gu32*)(ws + WS_CTL);
    for (int u = F.tid; u < (LDS_BYTES - LDSCTL_OFF) / 4; u += NWAVES * 64) ((LAS unsigned*)(F.lds + LDSCTL_OFF))[u] = 0u;
    __syncthreads();
    XcdBarrier bar = xcd_barrier_post((unsigned*)(F.ctl + CW_BAR), F.MISC + 8);
    const int lo = args.ph_lo, hi = args.ph_hi;
#define IN(k) (lo <= (k) && (k) < hi)
#define BOTH(k) (IN(k) && IN((k) + 1))
#define GRID_BAR() xcd_barrier(bar)
    float* KVT = (float*)((unsigned char*)args.out + OUT_KVT); bf16* SPREV = (bf16*)((unsigned char*)args.out + OUT_SPREV); float* DEC = (float*)(ws + WS_DEC);
    STAMP(0);
    if (IN(0)) { RUNPH(0, p0_prologue(F, args); p0_router_weights(F, args)); if (BOTH(0)) GRID_BAR(); }
    STAMP(1);
    if (IN(1)) {
        pg8::Gemm g{(const pg8::bf16_t*)(ws + WS_XB), (const pg8::bf16_t*)(ws + WS_WIN), M, NPROJ, D}; pg8::StaticOrder S; S.init(M, NPROJ, F.G, (int)blockIdx.x);
        EpiProj E{ws};
        RUNPH(1, pg8::gemm_phase<EpiProj, pg8::StaticOrder, true, true>(F.lds + RING_OFF, g, S, E));
        if (BOTH(1)) GRID_BAR();
    }
    STAMP(2);
    if (IN(2)) { RUNPH(2, sel_phase(F, args)); STAMP(3); RUNPH(3, gla_phase_a(F, args, KVT, DEC)); if (BOTH(2)) GRID_BAR(); }
    STAMP(4);
    if (IN(3)) { RUNPH(4, gla_phase_b(F, KVT, DEC, SPREV)); if (BOTH(3)) GRID_BAR(); }
    STAMP(5);
    if (IN(4)) {
        RUNPH(5, gla_phase_c(F, args, SPREV)); STAMP(6);
        static_assert(attn_body::ATTN_LDS_BYTES <= RING_BYTES, "attention LDS");
        const attn_body::AttnTensors AT{(const attn_body::bf16*)(ws + WS_AQ), (const attn_body::bf16*)(ws + WS_AK), (const attn_body::bf16*)(ws + WS_AV), (attn_body::bf16*)(ws + WS_Y), (const unsigned*)(ws + WS_MASK)};
        const attn_body::StaticOrder S((int)F.G, (int)blockIdx.x);
        RUNPH(6, attn_body::attn_phase<attn_body::StaticOrder>((char*)lds + RING_OFF, AT, S));
        if (BOTH(4)) GRID_BAR();
    }
    STAMP(7);
    if (IN(5)) {
        pg8::Gemm g{(const pg8::bf16_t*)(ws + WS_Y), (const pg8::bf16_t*)(ws + WS_WO), M, D, D}; pg8::StaticOrder S; S.init(M, D, F.G, (int)blockIdx.x);
        EpiMixBf16 E{(bf16*)(ws + WS_AQ)};
        RUNPH(7, pg8::gemm_phase<EpiMixBf16, pg8::StaticOrder, true, true>(F.lds + RING_OFF, g, S, E));
        if (BOTH(5)) GRID_BAR();
    }
    STAMP(8);
    if (IN(6)) { RUNPH(8, moe_ln1_route_phase(F, args, (const bf16*)(ws + WS_AQ), args.out, (bf16*)(ws + WS_HB))); if (BOTH(6)) GRID_BAR(); }
    STAMP(9);
    if (IN(7)) { }
    STAMP(10);
    if (IN(8)) { RUNPH(10, moe_assign_phase(F, args)); if (BOTH(8)) GRID_BAR(); }
    STAMP(11);
    if (IN(9)) {
        const int ntm = moe_tile_table(F, args);
        pg8::Gemm g{(const pg8::bf16_t*)(ws + WS_HB), (const pg8::bf16_t*)(ws + WS_WEI), 0, 0, 1024};
        MoeOrder S{ntm * 4, F.G, (int)blockIdx.x, F.lds + TILEE_OFF};
        EpiGateUp E{(bf16*)(ws + WS_HMID)};
        RUNPH(11, pg8::gemm_phase_gather<EpiGateUp, MoeOrder>(F.lds + RING_OFF, g, (const int*)(ws + WS_TOKROW), S, E));
        if (BOTH(9)) GRID_BAR();
    }
    STAMP(12);
    if (IN(10)) {
        const int ntm = moe_tile_table(F, args);
        pg8::Gemm g{(const pg8::bf16_t*)(ws + WS_HMID), (const pg8::bf16_t*)(ws + WS_WEO), 0, 0, 512};
        MoeOrder S{ntm * 4, F.G, (int)blockIdx.x, F.lds + TILEE_OFF};
        EpiScatter E{(bf16*)(ws + WS_FFN2), (const int*)(ws + WS_DEST), (const float*)(ws + WS_GPOS)};
        RUNPH(12, pg8::gemm_phase<EpiScatter, MoeOrder, true, true>(F.lds + RING_OFF, g, S, E));
        if (BOTH(10)) GRID_BAR();
    }
    STAMP(13);
    if (IN(11)) { ln2_phase(F, args, args.out, (const bf16*)(ws + WS_HB), (const bf16*)(ws + WS_FFN2)); }
#ifdef TIMING_A
    { STAMP(14);
      xcd_barrier(bar);
      const unsigned ta0 = __hip_atomic_load(F.ctl + 16 + 2 * TIMING_A, RLX_AGENT), ta1 = __hip_atomic_load(F.ctl + 16 + 2 * (TIMING_A + 1), RLX_AGENT);
      const unsigned tb0 = TIMING_B >= 14 ? 0u : __hip_atomic_load(F.ctl + 16 + 2 * TIMING_B, RLX_AGENT), tb1 = TIMING_B >= 14 ? 0u : __hip_atomic_load(F.ctl + 16 + 2 * (TIMING_B + 1), RLX_AGENT);
      const float sc = 1.f + 0.02f * rintf((float)(ta1 - ta0 + tb1 - tb0) * (1.f / 1000.f));
      for (size_t i = (size_t)blockIdx.x * 512 + F.tid; i < (size_t)M * D; i += (size_t)F.G * 512) args.out[i] *= sc; }
#endif
#undef IN
#undef BOTH
}

extern "C" void kernel_launch(void* const* d_in, const int* in_sizes, int n_in, void* d_out, int out_size, void* d_ws, size_t ws_size, hipStream_t stream) {
    static int grid = 0;
    if (grid == 0) {
        int dev = 0, cus = 0, per_cu = 0;
        if (hipGetDevice(&dev) != hipSuccess || hipDeviceGetAttribute(&cus, hipDeviceAttributeMultiprocessorCount, dev) != hipSuccess) { grid = -1; return; }
        if (hipFuncSetAttribute((const void*)mk_fwd, hipFuncAttributeMaxDynamicSharedMemorySize, LDS_BYTES) != hipSuccess) { grid = -1; return; }
        if (hipOccupancyMaxActiveBlocksPerMultiprocessor(&per_cu, (const void*)mk_fwd, NWAVES * 64, LDS_BYTES) != hipSuccess || per_cu < 1) { fprintf(stderr, "occupancy query: %d\n", per_cu); }
        (void)hipGetLastError();
        grid = cus;
    }
    if (grid < 0) return;
    (void)hipMemsetAsync((char*)d_ws + WS_CTL, 0, CTL_ZERO_BYTES, stream);
    Args a{};
    for (int i = 0; i < 16; ++i) a.in[i] = (const float*)d_in[i];
    a.out = (float*)d_out; a.ws = (unsigned char*)d_ws; a.ph_lo = 0; a.ph_hi = N_PHASES;
    hipLaunchKernelGGL(mk_fwd, dim3(grid), dim3(NWAVES * 64), LDS_BYTES, stream, a);
}
```
